# Optimizing an MI355X kernel written in HIP

```python
import jax, jax.numpy as jnp
from jax import lax
import numpy as np

D_MODEL = 1024
BATCH = 16
SEQ = 4096
DEPTH = 2

GDN_HEADS = 4
GDN_DK = 128
GDN_DV = 128
GDN_CONV = 4
GDN_CHUNK = 64
HG_HEADS = 4
HG_DF = 128
HG_DI = 128
HG_CHUNK = 16
N_BRANCH = 2
NORM_EPS = 1e-6

GDN_QK = GDN_HEADS * GDN_DK
GDN_V = GDN_HEADS * GDN_DV
HG_F = HG_HEADS * HG_DF
HG_I = HG_HEADS * HG_DI
SPLIT_SIZES = [2 * GDN_QK + GDN_V,
               GDN_HEADS,
               GDN_HEADS,
               GDN_V,
               HG_F,
               HG_F,
               HG_I,
               HG_I,
               N_BRANCH * D_MODEL]
IN_COLS = sum(SPLIT_SIZES)
SPLIT_IDX = [int(v) for v in np.cumsum(SPLIT_SIZES)[:-1]]

kernel_name = "hybrid_gdn_hgrn2_gated_merge"


def _rmsnorm(x, w):
    xf = x.astype(jnp.float32)
    y = xf * lax.rsqrt(jnp.mean(xf * xf, axis=-1, keepdims=True) + NORM_EPS)
    return (y * w.astype(jnp.float32)).astype(x.dtype)


def _l2norm(t):
    t = t.astype(jnp.float32)
    return t * lax.rsqrt(jnp.sum(t * t, axis=-1, keepdims=True) + NORM_EPS)


def _causal_depthwise_conv(x, w):
    k = w.shape[0]
    return lax.conv_general_dilated(
        x, w[:, None, :].astype(x.dtype), window_strides=(1,), padding=[(k - 1, 0)],
        dimension_numbers=("NWC", "WIO", "NWC"), feature_group_count=x.shape[-1])


def _masked_exp(diff, mask):
    return jnp.where(mask, jnp.exp(jnp.where(mask, diff, 0.0)), 0.0)


def _to_chunks(t, c):
    b, s, h = t.shape[:3]
    t = t.reshape((b, s // c, c, h) + t.shape[3:])
    return t.transpose((1, 0, 3, 2) + tuple(range(4, t.ndim)))


def _from_chunks(t):
    n, b, h, c = t.shape[:4]
    t = t.transpose((1, 0, 3, 2) + tuple(range(4, t.ndim)))
    return t.reshape((b, n * c, h) + t.shape[4:])


def _gated_delta_rule(q, k, v, g, beta):
    f32 = jnp.float32
    c = GDN_CHUNK
    dk, dv = q.shape[-1], v.shape[-1]
    q, k, v, g, beta = (_to_chunks(t.astype(f32), c) for t in (q, k, v, g, beta))
    G = jnp.cumsum(g, axis=-1)
    causal = jnp.tril(jnp.ones((c, c), bool))
    strict = jnp.tril(jnp.ones((c, c), bool), -1)
    L = _masked_exp(G[..., :, None] - G[..., None, :], causal)
    kb = k * beta[..., None]
    A = jnp.where(strict, jnp.einsum("nbhid,nbhjd->nbhij", kb, k) * L, 0.0)
    M = A + jnp.eye(c, dtype=f32)
    rhs = jnp.concatenate([v * beta[..., None], kb * jnp.exp(G)[..., None]], axis=-1)
    sol = lax.linalg.triangular_solve(M, rhs, left_side=True, lower=True, unit_diagonal=True)
    u, w = sol[..., :dv], sol[..., dv:]
    qs = q * (dk ** -0.5)
    a_qk = jnp.einsum("nbhid,nbhjd->nbhij", qs, k) * L
    qg = qs * jnp.exp(G)[..., None]
    kdec = k * jnp.exp(G[..., -1:] - G)[..., None]
    gl = jnp.exp(G[..., -1])

    def step(S, inp):
        u_c, w_c, qg_c, a_c, kd_c, gl_c = inp
        v_new = u_c - jnp.einsum("bhck,bhkv->bhcv", w_c, S)
        o = jnp.einsum("bhck,bhkv->bhcv", qg_c, S) + jnp.einsum("bhij,bhjv->bhiv", a_c, v_new)
        S = gl_c[..., None, None] * S + jnp.einsum("bhck,bhcv->bhkv", kd_c, v_new)
        return S, o

    S0 = jnp.zeros(q.shape[1:3] + (dk, dv), f32)
    _, o = lax.scan(step, S0, (u, w, qg, a_qk, kdec, gl))
    return _from_chunks(o)


def _hgrn2_chunked(q, k, v, log_f):
    f32 = jnp.float32
    c = HG_CHUNK
    q, k, v, log_f = (_to_chunks(t.astype(f32), c) for t in (q, k, v, log_f))
    G = jnp.cumsum(log_f, axis=-2)
    qg = q * jnp.exp(G)
    kdec = k * jnp.exp(G[..., -1:, :] - G)
    gl = jnp.exp(G[..., -1, :])
    causal = jnp.tril(jnp.ones((c, c), bool))[:, :, None]

    def step(S, inp):
        q_c, k_c, G_c, v_c, qg_c, kd_c, gl_c = inp
        D = _masked_exp(G_c[..., :, None, :] - G_c[..., None, :, :], causal)
        a = jnp.einsum("bhif,bhjf,bhijf->bhij", q_c, k_c, D)
        o = jnp.einsum("bhij,bhjv->bhiv", a, v_c) + jnp.einsum("bhcf,bhfv->bhcv", qg_c, S)
        S = gl_c[..., :, None] * S + jnp.einsum("bhcf,bhcv->bhfv", kd_c, v_c)
        return S, o

    S0 = jnp.zeros(q.shape[1:3] + (q.shape[-1], v.shape[-1]), f32)
    _, o = lax.scan(step, S0, (q, k, G, v, qg, kdec, gl))
    return _from_chunks(o)


def setup_inputs(seed: int = 0) -> dict:
    key = jax.random.key(seed)
    ks = jax.random.split(key, 12)
    f32 = jnp.float32
    x = jax.random.normal(ks[0], (BATCH, SEQ, D_MODEL), f32)
    norm_w = 1.0 + 0.02 * jax.random.normal(ks[1], (DEPTH, D_MODEL), f32)
    w_in = jax.random.normal(ks[2], (DEPTH, D_MODEL, IN_COLS), f32) * D_MODEL ** -0.5
    conv_w = jax.random.normal(ks[3], (DEPTH, GDN_CONV, 2 * GDN_QK + GDN_V), f32) * GDN_CONV ** -0.5
    a_log = jnp.log(jax.random.uniform(ks[4], (DEPTH, GDN_HEADS), f32, 1.0, 16.0))
    dt = jnp.exp(jax.random.uniform(ks[5], (DEPTH, GDN_HEADS), f32, np.log(1e-3), np.log(1e-1)))
    dt_bias = dt + jnp.log(-jnp.expm1(-dt))
    gdn_norm_w = 1.0 + 0.02 * jax.random.normal(ks[6], (DEPTH, GDN_DV), f32)
    hg_lb_logits = 0.1 * jax.random.normal(ks[7], (DEPTH, HG_F), f32)
    hg_norm_w = 1.0 + 0.02 * jax.random.normal(ks[8], (DEPTH, HG_DI), f32)
    w_branch = jax.random.normal(ks[9], (DEPTH, N_BRANCH, GDN_V, D_MODEL), f32) * GDN_V ** -0.5
    w_out = jax.random.normal(ks[10], (DEPTH, D_MODEL, D_MODEL), f32) * D_MODEL ** -0.5
    final_norm_w = 1.0 + 0.02 * jax.random.normal(ks[11], (D_MODEL,), f32)
    return {"x": x, "norm_w": norm_w, "w_in": w_in, "conv_w": conv_w, "a_log": a_log,
            "dt_bias": dt_bias, "gdn_norm_w": gdn_norm_w, "hg_lb_logits": hg_lb_logits,
            "hg_norm_w": hg_norm_w, "w_branch": w_branch, "w_out": w_out,
            "final_norm_w": final_norm_w}


def reference(x, norm_w, w_in, conv_w, a_log, dt_bias, gdn_norm_w, hg_lb_logits,
              hg_norm_w, w_branch, w_out, final_norm_w):
    f32 = jnp.float32
    b, s, _ = x.shape
    lb_p = jax.nn.softmax(hg_lb_logits.astype(f32), axis=0)
    lower_bounds = jnp.cumsum(lb_p, axis=0) - lb_p[0]
    h = x
    for l in range(DEPTH):
        xn = _rmsnorm(h, norm_w[l])
        proj = jnp.einsum("bsd,dc->bsc", xn, w_in[l])
        qkv, a_in, b_in, z_a, hq, hf, hi, z_b, gate = jnp.split(proj, SPLIT_IDX, axis=-1)

        qkv = jax.nn.silu(_causal_depthwise_conv(qkv, conv_w[l]))
        q, k, v = jnp.split(qkv, [GDN_QK, 2 * GDN_QK], axis=-1)
        q = _l2norm(q.reshape(b, s, GDN_HEADS, GDN_DK))
        k = _l2norm(k.reshape(b, s, GDN_HEADS, GDN_DK))
        v = v.reshape(b, s, GDN_HEADS, GDN_DV)
        g = -jnp.exp(a_log[l].astype(f32)) * jax.nn.softplus(a_in.astype(f32) + dt_bias[l].astype(f32))
        beta = jax.nn.sigmoid(b_in.astype(f32))
        o_a = _gated_delta_rule(q, k, v, g, beta)
        y_a = _rmsnorm(o_a, gdn_norm_w[l]) * jax.nn.silu(z_a.astype(f32).reshape(b, s, GDN_HEADS, GDN_DV))
        y_a = y_a.reshape(b, s, GDN_V).astype(x.dtype)

        lb = lower_bounds[l].reshape(HG_HEADS, HG_DF)
        f_logit = hf.astype(f32).reshape(b, s, HG_HEADS, HG_DF)
        f_gate = lb + (1.0 - lb) * jax.nn.sigmoid(f_logit)
        log_f = jnp.log(f_gate)
        k_h = (1.0 - lb) * jax.nn.sigmoid(-f_logit)
        o_b = _hgrn2_chunked(hq.reshape(b, s, HG_HEADS, HG_DF), k_h,
                             hi.reshape(b, s, HG_HEADS, HG_DI), log_f)
        y_b = _rmsnorm(o_b, hg_norm_w[l]) * jax.nn.silu(z_b.astype(f32).reshape(b, s, HG_HEADS, HG_DI))
        y_b = y_b.reshape(b, s, HG_I).astype(x.dtype)

        gate_a, gate_b = jnp.split(gate, 2, axis=-1)
        merged = (jax.nn.sigmoid(gate_a) * jnp.einsum("bsw,wd->bsd", y_a, w_branch[l, 0])
                  + jax.nn.sigmoid(gate_b) * jnp.einsum("bsw,wd->bsd", y_b, w_branch[l, 1]))
        h = h + jnp.einsum("bsd,de->bse", merged, w_out[l])
    return _rmsnorm(h, final_norm_w)
```

```cpp
#include <hip/hip_runtime.h>
#include <hip/hip_cooperative_groups.h>
#include <cstdio>
namespace cg = cooperative_groups;
namespace pg8 {
#define PG8_LAS __attribute__((address_space(3)))
typedef unsigned short bf16_t;
typedef short bf16x8 __attribute__((ext_vector_type(8)));
typedef float f32x4 __attribute__((ext_vector_type(4)));
typedef unsigned u32x4 __attribute__((ext_vector_type(4)));
constexpr int BM = 256, BK = 64, HALF = 128, HTB = HALF * BK * 2  , STAGE_BYTES = 8 * HTB, NXCD = 8, WGM = 8;

__host__ __device__ __forceinline__ int lds_byte(int r, int c) { const int st = (r >> 4) * 2 + (c >> 5), rr = r & 15, cc = c & 31, ob = rr * 64 + cc * 2; return st * 1024 + (ob ^ (((ob >> 9) & 1) << 5)); }
__host__ __device__ __forceinline__ void stage_rc(int b, int& R, int& C) { const int st = b / 1024, sb = b % 1024, swz = sb ^ (((sb >> 9) & 1) << 5); R = (st >> 1) * 16 + swz / 64; C = (st & 1) * 32 + (swz % 64) / 2; }
__host__ __device__ __forceinline__ int perm32(int rho) { const int n = rho >> 4, i = rho & 15; return 8 * (i >> 2) + 4 * n + (i & 3); }

struct Unit { int pm, pn; };
struct Gemm { const bf16_t* A; const bf16_t* Bt; int M, N, K; };

struct StaticOrder {
    int nM, nN, nwg, G, c;
    __host__ __device__ void init(int M, int N, int G_, int c_) { nM = M / BM; nN = N / BM; nwg = nM * nN; G = G_; c = c_; }
    __host__ __device__ bool next(int i, Unit& u) const {
        const long L = (long)i * G + c; if (L >= nwg) return false;
        int wgid = (int)L; { const int q = nwg / NXCD, r = nwg % NXCD, xcd = wgid % NXCD, off = wgid / NXCD; wgid = (xcd < r ? xcd * (q + 1) : r * (q + 1) + (xcd - r) * q) + off; }
        const int nig = WGM * nN, gid = wgid / nig, fm = gid * WGM, gsz = (nM - fm) < WGM ? (nM - fm) : WGM;
        u.pm = fm + ((wgid % nig) % gsz); u.pn = (wgid % nig) / gsz; return true;
    }
    __device__ __forceinline__ void a_ready(const Unit&) const {}
    __device__ __forceinline__ void done(const Unit&) const {}
};
__device__ __forceinline__ unsigned cvt_pk_bf16(float lo, float hi) { unsigned r; asm volatile("v_cvt_pk_bf16_f32 %0, %1, %2" : "=v"(r) : "v"(lo), "v"(hi)); return r; }
typedef float f32x2 __attribute__((ext_vector_type(2)));
template <class Epi, class Sched, bool STAMP = false>
__device__ __forceinline__ void gemm_phase(PG8_LAS unsigned char* lds, const Gemm g, const Sched& S, const Epi& E, unsigned long long* stamps) {
    int tid_ = threadIdx.x; asm volatile("" : "+v"(tid_));
    const int tid = tid_, wid = __builtin_amdgcn_readfirstlane(tid >> 6), lane = tid & 63, wr = wid >> 2, wc = wid & 3, fr = lane & 15, fq = lane >> 4;
    const int K = g.K, nt = K / BK;
#define PG8_STAMP() do {} while (0)
    PG8_STAMP();
    unsigned voffA[2], voffB[2];
#pragma unroll
    for (int i = 0; i < 2; ++i) { int R, C; stage_rc(tid * 16 + i * 8192, R, C); const int Rb = Epi::PERM ? ((R & ~31) + perm32(R & 31)) : R;
        voffA[i] = (unsigned)(R * K + C) * 2u; voffB[i] = (unsigned)(Rb * K + C) * 2u; }
    const size_t kstep = (size_t)(BK * 2);
    const size_t hstep = (size_t)HALF * K * 2;
    const size_t tstep = 2 * hstep;
    const unsigned ldsw = (unsigned)wid * 1024u;
    const int aoff = lds_byte(wr * 64 + fr, fq * 8), boff = lds_byte(wc * 32 + fr, fq * 8);
#define PG8_SA(b, h) (((b) * 2 + (h)) * HTB)
#define PG8_SB(b, h) ((4 + (b) * 2 + (h)) * HTB)
#define PG8_STAGE(bufoff, gbase, voff) do { _Pragma("unroll") for (int _i = 0; _i < 2; ++_i) \
        __builtin_amdgcn_global_load_lds((const unsigned*)((const char*)(gbase) + (voff)[_i]), (PG8_LAS unsigned*)(lds + (bufoff) + ldsw + _i * 8192), 16, 0, 0); } while (0)
#define PG8_LDA(dst, b, h) do { _Pragma("unroll") for (int m = 0; m < 4; ++m) _Pragma("unroll") for (int k = 0; k < 2; ++k) dst[m][k] = *(const PG8_LAS bf16x8*)(lds + PG8_SA(b, h) + aoff + m * 2048 + k * 1024); } while (0)
#define PG8_LDB(dst, b, h) do { _Pragma("unroll") for (int n = 0; n < 2; ++n) _Pragma("unroll") for (int k = 0; k < 2; ++k) dst[n][k] = *(const PG8_LAS bf16x8*)(lds + PG8_SB(b, h) + boff + n * 2048 + k * 1024); } while (0)
#define PG8_MMA(ai, bj, At, Bt) do { __builtin_amdgcn_s_setprio(1); _Pragma("unroll") for (int m = 0; m < 4; ++m) _Pragma("unroll") for (int n = 0; n < 2; ++n) _Pragma("unroll") for (int k = 0; k < 2; ++k) \
        acc[ai][bj][m][n] = __builtin_amdgcn_mfma_f32_16x16x32_bf16(Bt[n][k], At[m][k], acc[ai][bj][m][n], 0, 0, 0); __builtin_amdgcn_s_setprio(0); } while (0)
#define PG8_WAIT_V(n) asm volatile("s_waitcnt vmcnt(" #n ")" ::: "memory")
#define PG8_WAIT_L(n) asm volatile("s_waitcnt lgkmcnt(" #n ")" ::: "memory")
#define PG8_BAR __builtin_amdgcn_s_barrier()
#define PG8_SCHED __builtin_amdgcn_sched_barrier(0)
    Unit cur, nxt; int ui = 0;
    if (!S.next(0, cur)) return;
    f32x4 acc[2][2][4][2];
#pragma unroll
    for (int a = 0; a < 2; ++a)
#pragma unroll
        for (int b = 0; b < 2; ++b)
#pragma unroll
            for (int m = 0; m < 4; ++m)
#pragma unroll
                for (int n = 0; n < 2; ++n) acc[a][b][m][n] = (f32x4){0.f, 0.f, 0.f, 0.f};
    bf16x8 At[4][2], B0[2][2], B1[2][2];
    const char* cA = (const char*)g.A + (size_t)cur.pm * tstep; const char* cB = (const char*)g.Bt + (size_t)cur.pn * tstep;
    S.a_ready(cur);
    PG8_STAGE(PG8_SB(0, 0), cB, voffB); PG8_STAGE(PG8_SA(0, 0), cA, voffA); PG8_STAGE(PG8_SB(0, 1), cB + hstep, voffB); PG8_STAGE(PG8_SA(0, 1), cA + hstep, voffA);
    if (wr == 1) PG8_BAR;
    PG8_WAIT_V(4); PG8_BAR;
    PG8_STAGE(PG8_SB(1, 0), cB + kstep, voffB); PG8_STAGE(PG8_SA(1, 0), cA + kstep, voffA); PG8_STAGE(PG8_SB(1, 1), cB + hstep + kstep, voffB);
    PG8_WAIT_V(6); PG8_BAR;
    PG8_STAMP();
    for (;;) {
        const bool has_next = S.next(ui + 1, nxt);
        const char* nA = has_next ? (const char*)g.A + (size_t)nxt.pm * tstep : cA; const char* nB = has_next ? (const char*)g.Bt + (size_t)nxt.pn * tstep : cB;
        for (int t = 0; t < nt; t += 2) {
            const bool last = (t == nt - 2);
            const char* a1 = cA + (size_t)(t + 1) * kstep;
            const char* a2 = last ? nA : cA + (size_t)(t + 2) * kstep; const char* b2 = last ? nB : cB + (size_t)(t + 2) * kstep;
            const char* a3 = a2 + kstep; const char* b3 = b2 + kstep;
            if (last && has_next) S.a_ready(nxt);
            PG8_LDB(B0, 0, 0); PG8_SCHED; PG8_LDA(At, 0, 0); PG8_STAGE(PG8_SA(1, 1), a1 + hstep, voffA);
            PG8_WAIT_L(8); PG8_BAR; PG8_WAIT_L(0); PG8_MMA(0, 0, At, B0); PG8_BAR; PG8_SCHED;
            PG8_LDB(B1, 0, 1); PG8_STAGE(PG8_SB(0, 0), b2, voffB);
            PG8_BAR; PG8_WAIT_L(0); PG8_MMA(0, 1, At, B1); PG8_BAR;
            PG8_LDA(At, 0, 1); PG8_STAGE(PG8_SA(0, 0), a2, voffA);
            PG8_BAR; PG8_WAIT_L(0); PG8_MMA(1, 0, At, B0); PG8_BAR; PG8_SCHED;
            PG8_STAGE(PG8_SB(0, 1), b2 + hstep, voffB);
            PG8_WAIT_V(6); PG8_BAR; PG8_MMA(1, 1, At, B1); PG8_BAR;
            PG8_LDB(B0, 1, 0); PG8_SCHED; PG8_LDA(At, 1, 0); PG8_STAGE(PG8_SA(0, 1), a2 + hstep, voffA);
            PG8_WAIT_L(8); PG8_BAR; PG8_WAIT_L(0); PG8_MMA(0, 0, At, B0); PG8_BAR; PG8_SCHED;
            PG8_LDB(B1, 1, 1); PG8_STAGE(PG8_SB(1, 0), b3, voffB);
            PG8_BAR; PG8_WAIT_L(0); PG8_MMA(0, 1, At, B1); PG8_BAR;
            PG8_LDA(At, 1, 1); PG8_STAGE(PG8_SA(1, 0), a3, voffA);
            PG8_BAR; PG8_WAIT_L(0); PG8_MMA(1, 0, At, B0); PG8_BAR; PG8_SCHED;
            PG8_STAGE(PG8_SB(1, 1), b3 + hstep, voffB);
            PG8_WAIT_V(6); PG8_BAR; PG8_MMA(1, 1, At, B1); PG8_BAR;
        }
        PG8_STAMP();
        if constexpr (!Epi::AFTER_DRAIN) { E(acc, cur, wr, wc, fr, fq); S.done(cur); }
        PG8_STAMP();
        if (!has_next) break;
#pragma unroll
        for (int a = 0; a < 2; ++a)
#pragma unroll
            for (int b = 0; b < 2; ++b)
#pragma unroll
                for (int m = 0; m < 4; ++m)
#pragma unroll
                    for (int n = 0; n < 2; ++n) acc[a][b][m][n] = (f32x4){0.f, 0.f, 0.f, 0.f};
        cur = nxt; cA = nA; cB = nB; ++ui;
    }
    PG8_WAIT_V(0);
    if (wr == 0) PG8_BAR;
    PG8_BAR;
    if constexpr (Epi::AFTER_DRAIN) { E.fused(acc, cur, wr, wc, fr, fq, lds, wid, lane); S.done(cur); }
    PG8_STAMP();
#undef PG8_STAMP
#undef PG8_SA
#undef PG8_SB
#undef PG8_STAGE
#undef PG8_LDA
#undef PG8_LDB
#undef PG8_MMA
#undef PG8_WAIT_V
#undef PG8_WAIT_L
#undef PG8_BAR
#undef PG8_SCHED
}
}

using pg8::bf16_t; using pg8::f32x4; using pg8::u32x4;
typedef float f32x2v __attribute__((ext_vector_type(2)));
#define LAS __attribute__((address_space(3)))
constexpr int DM = 1024, NB = 16, SEQ = 4096, MTOK = NB * SEQ, DEPTH = 2, INC = 6152, NPROJ = 6144, PW = 2048;
constexpr float EPS = 1e-6f;
constexpr int LDS_BYTES = 131072;
constexpr size_t SZ_P = (size_t)MTOK * PW * 2;
constexpr size_t WS_P0 = 0, WS_P1 = SZ_P, WS_P2 = 2 * SZ_P, WS_XN = 3 * SZ_P;
constexpr size_t SZ_XN = (size_t)MTOK * DM * 2;
constexpr size_t WS_W = WS_XN + SZ_XN;
constexpr size_t SZ_WIN = (size_t)NPROJ * DM * 2, SZ_WB = (size_t)DM * 512 * 2, SZ_WO = (size_t)DM * DM * 2;
constexpr size_t SZ_WL = SZ_WIN + 2 * SZ_WB + SZ_WO;
constexpr size_t WS_G = WS_W + DEPTH * SZ_WL;
constexpr size_t SZ_G = (size_t)MTOK * 4 * 4;
constexpr size_t WS_BETA = WS_G + SZ_G;
constexpr size_t WS_END = WS_BETA + SZ_G;

struct Params {
    const float* x; const float* norm_w; const float* w_in; const float* conv_w; const float* a_log; const float* dt_bias;
    const float* gdn_norm_w; const float* hg_lb; const float* hg_norm_w; const float* w_branch; const float* w_out; const float* final_norm_w;
    float* out; unsigned char* ws;
};

typedef const __attribute__((address_space(4))) Params* KP;
__device__ __forceinline__ float bflo(unsigned u) { return __uint_as_float(u << 16); }
__device__ __forceinline__ float bfhi(unsigned u) { return __uint_as_float(u & 0xffff0000u); }
__device__ __forceinline__ bf16_t f2bf(float f) { unsigned u = __float_as_uint(f); u += 0x7FFFu + ((u >> 16) & 1u); return (bf16_t)(u >> 16); }
__device__ __forceinline__ float sigm(float x) { return 1.f / (1.f + __expf(-x)); }
__device__ __forceinline__ float silu(float x) { return x / (1.f + __expf(-x)); }
__device__ __forceinline__ void unpack8(const uint4 u, float (&f)[8]) { f[0] = bflo(u.x); f[1] = bfhi(u.x); f[2] = bflo(u.y); f[3] = bfhi(u.y); f[4] = bflo(u.z); f[5] = bfhi(u.z); f[6] = bflo(u.w); f[7] = bfhi(u.w); }
__device__ __forceinline__ uint4 pack8(const float (&f)[8]) { uint4 u; u.x = pg8::cvt_pk_bf16(f[0], f[1]); u.y = pg8::cvt_pk_bf16(f[2], f[3]); u.z = pg8::cvt_pk_bf16(f[4], f[5]); u.w = pg8::cvt_pk_bf16(f[6], f[7]); return u; }
template <int CTRL> __device__ __forceinline__ float dppf(float x) { return __int_as_float(__builtin_amdgcn_update_dpp(0, __float_as_int(x), CTRL, 0xf, 0xf, true)); }
__device__ __forceinline__ float sum8(float x) { x += dppf<0xB1>(x); x += dppf<0x4E>(x); x += dppf<0x141>(x); return x; }
__device__ __forceinline__ float sum16(float x) { x = sum8(x); x += dppf<0x140>(x); return x; }
__device__ __forceinline__ float sum64(float x) { x = sum16(x); x += __shfl_xor(x, 16); x += __shfl_xor(x, 32); return x; }

struct EpiSplit {
    static constexpr bool PERM = true, AFTER_DRAIN = false;
    bf16_t* O;
    __device__ __forceinline__ void operator()(const f32x4 (&acc)[2][2][4][2], const pg8::Unit& u, int wr, int wc, int fr, int fq) const {
        const int row0 = u.pm * 256 + wr * 64 + fr; int colt = u.pn * 256; const int t = colt / PW; colt -= t * PW;
        bf16_t* base = O + (size_t)t * MTOK * PW; const int col0 = colt + wc * 32 + 8 * fq;
#pragma unroll
        for (int ai = 0; ai < 2; ++ai)
#pragma unroll
            for (int m = 0; m < 4; ++m) { bf16_t* rowp = base + (size_t)(row0 + ai * 128 + m * 16) * PW + col0;
#pragma unroll
                for (int bj = 0; bj < 2; ++bj) { const f32x4 v0 = acc[ai][bj][m][0], v1 = acc[ai][bj][m][1];
                    u32x4 w; w.x = pg8::cvt_pk_bf16(v0[0], v0[1]); w.y = pg8::cvt_pk_bf16(v0[2], v0[3]); w.z = pg8::cvt_pk_bf16(v1[0], v1[1]); w.w = pg8::cvt_pk_bf16(v1[2], v1[3]);
                    *(u32x4*)(rowp + bj * 128) = w; } }
    }
};
template <bool ADD> struct EpiGate {
    static constexpr bool PERM = true, AFTER_DRAIN = false;
    bf16_t* O; const bf16_t* gate; const bf16_t* addsrc;
    __device__ __forceinline__ void operator()(const f32x4 (&acc)[2][2][4][2], const pg8::Unit& u, int wr, int wc, int fr, int fq) const {
        const int row0 = u.pm * 256 + wr * 64 + fr; const int col0 = u.pn * 256 + wc * 32 + 8 * fq;
#pragma unroll
        for (int ai = 0; ai < 2; ++ai)
#pragma unroll
            for (int m = 0; m < 4; ++m) { const size_t r = (size_t)(row0 + ai * 128 + m * 16);
#pragma unroll
                for (int bj = 0; bj < 2; ++bj) { const int c = col0 + bj * 128;
                    const uint4 gu = *(const uint4*)(gate + r * PW + c); float gf[8]; unpack8(gu, gf);
                    const f32x4 v0 = acc[ai][bj][m][0], v1 = acc[ai][bj][m][1];
                    float v[8] = {v0[0], v0[1], v0[2], v0[3], v1[0], v1[1], v1[2], v1[3]};
#pragma unroll
                    for (int j = 0; j < 8; ++j) v[j] *= sigm(gf[j]);
                    if (ADD) { const uint4 au = *(const uint4*)(addsrc + r * DM + c); float af[8]; unpack8(au, af);
#pragma unroll
                        for (int j = 0; j < 8; ++j) v[j] += af[j]; }
                    *(uint4*)(O + r * DM + c) = pack8(v); } }
    }
};
struct EpiRes {
    static constexpr bool PERM = false, AFTER_DRAIN = false;
    const float* base; float* out;
    __device__ __forceinline__ void operator()(const f32x4 (&acc)[2][2][4][2], const pg8::Unit& u, int wr, int wc, int fr, int fq) const {
        const int row0 = u.pm * 256 + wr * 64 + fr, col0 = u.pn * 256 + wc * 32 + 4 * fq;
#pragma unroll
        for (int ai = 0; ai < 2; ++ai)
#pragma unroll
            for (int m = 0; m < 4; ++m) { const size_t off = (size_t)(row0 + ai * 128 + m * 16) * DM + col0;
#pragma unroll
                for (int bj = 0; bj < 2; ++bj)
#pragma unroll
                    for (int n = 0; n < 2; ++n) { const size_t o2 = off + bj * 128 + n * 16; *(f32x4*)(out + o2) = *(const f32x4*)(base + o2) + acc[ai][bj][m][n]; } }
    }
};

__device__ void convT(const float* src, int ld, int col0, int N, int K, bf16_t* dst, LAS float* tile) {
    const int tid = threadIdx.x; const int ntn = N / 64, ntk = K / 64;
    for (int t = blockIdx.x; t < ntn * ntk; t += gridDim.x) {
        const int n0 = (t % ntn) * 64, k0 = (t / ntn) * 64;
        { const int kk = tid >> 6, nn = tid & 63;
#pragma unroll
          for (int i = 0; i < 8; ++i) tile[(kk + 8 * i) * 65 + nn] = src[(size_t)(k0 + kk + 8 * i) * ld + col0 + n0 + nn]; }
        __syncthreads();
        { const int nn = tid >> 6, kk = tid & 63;
#pragma unroll
          for (int i = 0; i < 8; ++i) dst[(size_t)(n0 + nn + 8 * i) * K + k0 + kk] = f2bf(tile[kk * 65 + nn + 8 * i]); }
        __syncthreads();
    }
}
__device__ void phase_weights(KP p, LAS float* tile) {
    for (int l = 0; l < DEPTH; ++l) {
        unsigned char* wl = p->ws + WS_W + (size_t)l * SZ_WL;
        const float* win = p->w_in + (size_t)l * DM * INC;
        convT(win, INC, 0, 1536, DM, (bf16_t*)wl, tile);
        convT(win, INC, 1544, NPROJ - 1536, DM, (bf16_t*)wl + (size_t)1536 * DM, tile);
        convT(p->w_branch + (size_t)(l * 2 + 0) * 512 * DM, DM, 0, DM, 512, (bf16_t*)(wl + SZ_WIN), tile);
        convT(p->w_branch + (size_t)(l * 2 + 1) * 512 * DM, DM, 0, DM, 512, (bf16_t*)(wl + SZ_WIN + SZ_WB), tile);
        convT(p->w_out + (size_t)l * DM * DM, DM, 0, DM, DM, (bf16_t*)(wl + SZ_WIN + 2 * SZ_WB), tile);
    }
}

__device__ void phase_norm(KP p, int l, const float* hsrc, LAS float* wab) {
    const int tid = threadIdx.x, lane = tid & 63, wave = tid >> 6;
    const float* win = p->w_in + (size_t)l * DM * INC;
    __syncthreads();
    for (int i = tid; i < 8192; i += 512) { const int k = i >> 3, j = i & 7; wab[j * 1024 + k] = win[(size_t)k * INC + 1536 + j]; }
    __syncthreads();
    const float* nw = p->norm_w + l * DM;
    bf16_t* XN = (bf16_t*)(p->ws + WS_XN); float* G = (float*)(p->ws + WS_G); float* BT = (float*)(p->ws + WS_BETA);
    float4 nwv[4];
#pragma unroll
    for (int c = 0; c < 4; ++c) nwv[c] = *(const float4*)(nw + c * 256 + lane * 4);
    const float alog = p->a_log[l * 4 + (lane & 3)], dtb = p->dt_bias[l * 4 + (lane & 3)];
    for (int row = blockIdx.x * 8 + wave; row < MTOK; row += gridDim.x * 8) {
        const float* hr = hsrc + (size_t)row * DM;
        float4 v[4]; float ss = 0.f;
#pragma unroll
        for (int c = 0; c < 4; ++c) { v[c] = *(const float4*)(hr + c * 256 + lane * 4); ss += v[c].x * v[c].x + v[c].y * v[c].y + v[c].z * v[c].z + v[c].w * v[c].w; }
        ss = sum64(ss);
        const float rstd = rsqrtf(ss * (1.f / DM) + EPS);
        float acc[8];
#pragma unroll
        for (int j = 0; j < 8; ++j) acc[j] = 0.f;
#pragma unroll
        for (int c = 0; c < 4; ++c) {
            const float x0 = v[c].x * rstd * nwv[c].x, x1 = v[c].y * rstd * nwv[c].y, x2 = v[c].z * rstd * nwv[c].z, x3 = v[c].w * rstd * nwv[c].w;
            uint2 pk; pk.x = pg8::cvt_pk_bf16(x0, x1); pk.y = pg8::cvt_pk_bf16(x2, x3);
            *(uint2*)(XN + (size_t)row * DM + c * 256 + lane * 4) = pk;
#pragma unroll
            for (int j = 0; j < 8; ++j) { const f32x4 w = *(const LAS f32x4*)(wab + j * 1024 + c * 256 + lane * 4); acc[j] += x0 * w[0] + x1 * w[1] + x2 * w[2] + x3 * w[3]; }
        }
#pragma unroll
        for (int j = 0; j < 8; ++j) acc[j] = sum64(acc[j]);
        if (lane < 4) {
            const float a = lane == 0 ? acc[0] : lane == 1 ? acc[1] : lane == 2 ? acc[2] : acc[3];
            const float bb = lane == 0 ? acc[4] : lane == 1 ? acc[5] : lane == 2 ? acc[6] : acc[7];
            const float z = a + dtb; const float sp = z > 20.f ? z : log1pf(expf(z));
            G[(size_t)row * 4 + lane] = -expf(alog) * sp;
            BT[(size_t)row * 4 + lane] = 1.f / (1.f + expf(-bb));
        }
    }
}

__device__ void phase_rec(KP p, int l, LAS float* lds) {
    int tid_ = threadIdx.x; asm volatile("" : "+v"(tid_));
    const int tid = tid_, lane = tid & 63, wave = tid >> 6;
    LAS float* sq = lds; LAS float* sk = lds + 8192; LAS float* sv = lds + 16384; LAS float* so = lds + 20480;
    LAS float* seg = lds + 24576; LAS float* sbe = seg + 64; LAS float* scw = seg + 128; LAS float* slb = scw + 1280;
    const float* G = (const float*)(p->ws + WS_G); const float* BT = (const float*)(p->ws + WS_BETA);
    bf16_t* OA = (bf16_t*)(p->ws + WS_XN); bf16_t* OB = OA + (size_t)MTOK * 512;
    const int r = lane & 15, cp = wave * 4 + (lane >> 4);
    const int tok = tid >> 3, sub = tid & 7;
    for (int item = blockIdx.x; item < 256; item += gridDim.x) {
        const int br = item >> 7, idx = item & 127, b = idx >> 3, h = (idx >> 1) & 3, half = idx & 1;
        __syncthreads();
        if (br == 0) {
            for (int i = tid; i < 1280; i += 512) { const int j = i / 320, cc = i % 320;
                const int ch = cc < 128 ? h * 128 + cc : (cc < 256 ? 512 + h * 128 + (cc - 128) : 1024 + h * 128 + half * 64 + (cc - 256));
                scw[i] = p->conv_w[(size_t)(l * 4 + j) * 1536 + ch]; }
        } else {
            if (tid < 128) { const int c = h * 128 + tid; float mx = -1e30f;
                for (int i = 0; i < DEPTH; ++i) mx = fmaxf(mx, p->hg_lb[i * 512 + c]);
                float den = 0.f, num = 0.f;
                for (int i = 0; i < DEPTH; ++i) { const float e = expf(p->hg_lb[i * 512 + c] - mx); den += e; if (i >= 1 && i <= l) num += e; }
                slb[tid] = num / den; }
        }
        float S[8][2];
#pragma unroll
        for (int i = 0; i < 8; ++i) { S[i][0] = 0.f; S[i][1] = 0.f; }
        const bf16_t* PB = (const bf16_t*)(p->ws + (br ? WS_P1 : WS_P0));
        bf16_t* OUT = br ? OB : OA;
        for (int ck = 0; ck < SEQ / 64; ++ck) {
            __syncthreads();
            const int s = ck * 64 + tok; const size_t rowg = (size_t)b * SEQ + s;
            if (br == 0) {
                float qv[16], kv[16], vv[8];
#pragma unroll
                for (int i = 0; i < 16; ++i) { qv[i] = 0.f; kv[i] = 0.f; }
#pragma unroll
                for (int i = 0; i < 8; ++i) vv[i] = 0.f;
#pragma unroll
                for (int j = 0; j < 4; ++j) {
                    if (s - 3 + j >= 0) {
                        const bf16_t* rp = PB + (rowg - 3 + j) * PW;
                        float t8[8];
                        LAS float* cw = scw + j * 320;
                        unpack8(*(const uint4*)(rp + h * 128 + sub * 16), t8);
#pragma unroll
                        for (int i = 0; i < 8; ++i) qv[i] += t8[i] * cw[sub * 16 + i];
                        unpack8(*(const uint4*)(rp + h * 128 + sub * 16 + 8), t8);
#pragma unroll
                        for (int i = 0; i < 8; ++i) qv[8 + i] += t8[i] * cw[sub * 16 + 8 + i];
                        unpack8(*(const uint4*)(rp + 512 + h * 128 + sub * 16), t8);
#pragma unroll
                        for (int i = 0; i < 8; ++i) kv[i] += t8[i] * cw[128 + sub * 16 + i];
                        unpack8(*(const uint4*)(rp + 512 + h * 128 + sub * 16 + 8), t8);
#pragma unroll
                        for (int i = 0; i < 8; ++i) kv[8 + i] += t8[i] * cw[128 + sub * 16 + 8 + i];
                        unpack8(*(const uint4*)(rp + 1024 + h * 128 + half * 64 + sub * 8), t8);
#pragma unroll
                        for (int i = 0; i < 8; ++i) vv[i] += t8[i] * cw[256 + sub * 8 + i];
                    }
                }
                float sqq = 0.f, skk = 0.f;
#pragma unroll
                for (int i = 0; i < 16; ++i) { qv[i] = silu(qv[i]); kv[i] = silu(kv[i]); sqq += qv[i] * qv[i]; skk += kv[i] * kv[i]; }
#pragma unroll
                for (int i = 0; i < 8; ++i) vv[i] = silu(vv[i]);
                sqq = sum8(sqq); skk = sum8(skk);
                const float rq = rsqrtf(sqq + EPS) * 0.08838834764831845f, rk = rsqrtf(skk + EPS);
#pragma unroll
                for (int i = 0; i < 16; ++i) { sq[tok * 128 + sub * 16 + i] = qv[i] * rq; sk[tok * 128 + sub * 16 + i] = kv[i] * rk; }
#pragma unroll
                for (int i = 0; i < 8; ++i) sv[tok * 64 + sub * 8 + i] = vv[i];
                if (sub == 0) { seg[tok] = __expf(G[rowg * 4 + h]); sbe[tok] = BT[rowg * 4 + h]; }
            } else {
                const bf16_t* rp = PB + rowg * PW;
                float t8[8];
                unpack8(*(const uint4*)(rp + h * 128 + sub * 16), t8);
#pragma unroll
                for (int i = 0; i < 8; ++i) sq[tok * 128 + sub * 16 + i] = t8[i];
                unpack8(*(const uint4*)(rp + h * 128 + sub * 16 + 8), t8);
#pragma unroll
                for (int i = 0; i < 8; ++i) sq[tok * 128 + sub * 16 + 8 + i] = t8[i];
                unpack8(*(const uint4*)(rp + 512 + h * 128 + sub * 16), t8);
#pragma unroll
                for (int i = 0; i < 8; ++i) { const float lb = slb[sub * 16 + i]; sk[tok * 128 + sub * 16 + i] = lb + (1.f - lb) * sigm(t8[i]); }
                unpack8(*(const uint4*)(rp + 512 + h * 128 + sub * 16 + 8), t8);
#pragma unroll
                for (int i = 0; i < 8; ++i) { const float lb = slb[sub * 16 + 8 + i]; sk[tok * 128 + sub * 16 + 8 + i] = lb + (1.f - lb) * sigm(t8[i]); }
                unpack8(*(const uint4*)(rp + 1024 + h * 128 + half * 64 + sub * 8), t8);
#pragma unroll
                for (int i = 0; i < 8; ++i) sv[tok * 64 + sub * 8 + i] = t8[i];
            }
            __syncthreads();
            if (br == 0) {
                for (int t = 0; t < 64; ++t) {
                    const f32x4 k0 = *(const LAS f32x4*)(sk + t * 128 + r * 8), k1 = *(const LAS f32x4*)(sk + t * 128 + r * 8 + 4);
                    const f32x4 q0 = *(const LAS f32x4*)(sq + t * 128 + r * 8), q1 = *(const LAS f32x4*)(sq + t * 128 + r * 8 + 4);
                    const f32x2v v2 = *(const LAS f32x2v*)(sv + t * 64 + cp * 2);
                    const float eg = seg[t], be = sbe[t];
                    const float kk[8] = {k0[0], k0[1], k0[2], k0[3], k1[0], k1[1], k1[2], k1[3]};
                    const float qq[8] = {q0[0], q0[1], q0[2], q0[3], q1[0], q1[1], q1[2], q1[3]};
                    float p0 = 0.f, p1 = 0.f;
#pragma unroll
                    for (int i = 0; i < 8; ++i) { p0 += kk[i] * S[i][0]; p1 += kk[i] * S[i][1]; }
                    p0 = sum16(p0); p1 = sum16(p1);
                    const float d0 = be * (v2[0] - eg * p0), d1 = be * (v2[1] - eg * p1);
                    float o0 = 0.f, o1 = 0.f;
#pragma unroll
                    for (int i = 0; i < 8; ++i) { S[i][0] = eg * S[i][0] + kk[i] * d0; S[i][1] = eg * S[i][1] + kk[i] * d1; o0 += qq[i] * S[i][0]; o1 += qq[i] * S[i][1]; }
                    o0 = sum16(o0); o1 = sum16(o1);
                    if (r == 0) *(LAS f32x2v*)(so + t * 64 + cp * 2) = (f32x2v){o0, o1};
                }
            } else {
                for (int t = 0; t < 64; ++t) {
                    const f32x4 k0 = *(const LAS f32x4*)(sk + t * 128 + r * 8), k1 = *(const LAS f32x4*)(sk + t * 128 + r * 8 + 4);
                    const f32x4 q0 = *(const LAS f32x4*)(sq + t * 128 + r * 8), q1 = *(const LAS f32x4*)(sq + t * 128 + r * 8 + 4);
                    const f32x2v v2 = *(const LAS f32x2v*)(sv + t * 64 + cp * 2);
                    const float ff[8] = {k0[0], k0[1], k0[2], k0[3], k1[0], k1[1], k1[2], k1[3]};
                    const float qq[8] = {q0[0], q0[1], q0[2], q0[3], q1[0], q1[1], q1[2], q1[3]};
                    float o0 = 0.f, o1 = 0.f;
#pragma unroll
                    for (int i = 0; i < 8; ++i) { const float kf = 1.f - ff[i]; S[i][0] = ff[i] * S[i][0] + kf * v2[0]; S[i][1] = ff[i] * S[i][1] + kf * v2[1]; o0 += qq[i] * S[i][0]; o1 += qq[i] * S[i][1]; }
                    o0 = sum16(o0); o1 = sum16(o1);
                    if (r == 0) *(LAS f32x2v*)(so + t * 64 + cp * 2) = (f32x2v){o0, o1};
                }
            }
            __syncthreads();
            { float o8[8];
#pragma unroll
              for (int i = 0; i < 8; ++i) o8[i] = so[tok * 64 + sub * 8 + i];
              *(uint4*)(OUT + rowg * 512 + h * 128 + half * 64 + sub * 8) = pack8(o8); }
        }
    }
}

__device__ void phase_gn(KP p, int l) {
    const int tid = threadIdx.x, lane = tid & 63, wave = tid >> 6;
    bf16_t* OA = (bf16_t*)(p->ws + WS_XN); bf16_t* OB = OA + (size_t)MTOK * 512;
    for (int wi = blockIdx.x * 8 + wave; wi < MTOK * 2; wi += gridDim.x * 8) {
        const int br = wi & 1; const size_t row = (size_t)(wi >> 1);
        bf16_t* O = (br ? OB : OA) + row * 512 + lane * 8;
        const bf16_t* Z = (const bf16_t*)(p->ws + (br ? WS_P1 : WS_P0)) + row * PW + 1536 + lane * 8;
        const float* nw = (br ? p->hg_norm_w : p->gdn_norm_w) + l * 128 + (lane & 15) * 8;
        float o[8], z[8]; unpack8(*(const uint4*)O, o); unpack8(*(const uint4*)Z, z);
        float ss = 0.f;
#pragma unroll
        for (int i = 0; i < 8; ++i) ss += o[i] * o[i];
        ss = sum16(ss);
        const float rstd = rsqrtf(ss * (1.f / 128.f) + EPS);
        const float4 w0 = *(const float4*)nw, w1 = *(const float4*)(nw + 4);
        const float wv[8] = {w0.x, w0.y, w0.z, w0.w, w1.x, w1.y, w1.z, w1.w};
#pragma unroll
        for (int i = 0; i < 8; ++i) o[i] = o[i] * rstd * wv[i] * silu(z[i]);
        *(uint4*)O = pack8(o);
    }
}

__device__ void phase_final(KP p) {
    const int tid = threadIdx.x, lane = tid & 63, wave = tid >> 6;
    float4 nwv[4];
#pragma unroll
    for (int c = 0; c < 4; ++c) nwv[c] = *(const float4*)(p->final_norm_w + c * 256 + lane * 4);
    for (int row = blockIdx.x * 8 + wave; row < MTOK; row += gridDim.x * 8) {
        float* hr = p->out + (size_t)row * DM;
        float4 v[4]; float ss = 0.f;
#pragma unroll
        for (int c = 0; c < 4; ++c) { v[c] = *(const float4*)(hr + c * 256 + lane * 4); ss += v[c].x * v[c].x + v[c].y * v[c].y + v[c].z * v[c].z + v[c].w * v[c].w; }
        ss = sum64(ss);
        const float rstd = rsqrtf(ss * (1.f / DM) + EPS);
#pragma unroll
        for (int c = 0; c < 4; ++c) { float4 o; o.x = v[c].x * rstd * nwv[c].x; o.y = v[c].y * rstd * nwv[c].y; o.z = v[c].z * rstd * nwv[c].z; o.w = v[c].w * rstd * nwv[c].w;
            *(float4*)(hr + c * 256 + lane * 4) = o; }
    }
}

__global__ void __launch_bounds__(512, 2) fwd_kernel(Params p_arg) {
    extern __shared__ __attribute__((aligned(16))) unsigned char smem[];
    cg::grid_group grid = cg::this_grid();
    LAS unsigned char* lds = (LAS unsigned char*)smem;
    KP p = (KP)__builtin_amdgcn_kernarg_segment_ptr();
#define RELOAD() asm volatile("" : "+s"(p))
#ifndef NO_W
    phase_weights(p, (LAS float*)lds);
#endif
    RELOAD();
#ifndef NO_N
    phase_norm(p, 0, p->x, (LAS float*)lds);
#endif
    grid.sync();
    for (int l = 0; l < DEPTH; ++l) {
        RELOAD();
#ifndef NO_G1
        { unsigned char* ws = p->ws;
          pg8::Gemm g{(const bf16_t*)(ws + WS_XN), (const bf16_t*)(ws + WS_W + (size_t)l * SZ_WL), MTOK, NPROJ, DM}; pg8::StaticOrder S; S.init(MTOK, NPROJ, (int)gridDim.x, (int)blockIdx.x);
          EpiSplit E{(bf16_t*)(ws + WS_P0)}; pg8::gemm_phase<EpiSplit, pg8::StaticOrder, false>(lds, g, S, E, nullptr); }
#endif
        grid.sync();
        RELOAD();
#ifndef NO_R
        phase_rec(p, l, (LAS float*)lds);
#endif
        grid.sync();
        RELOAD();
#ifndef NO_GN
        phase_gn(p, l);
#endif
        grid.sync();
        RELOAD();
#ifndef NO_B1
        { unsigned char* ws = p->ws;
          pg8::Gemm g{(const bf16_t*)(ws + WS_XN), (const bf16_t*)(ws + WS_W + (size_t)l * SZ_WL + SZ_WIN), MTOK, DM, 512}; pg8::StaticOrder S; S.init(MTOK, DM, (int)gridDim.x, (int)blockIdx.x);
          EpiGate<false> E{(bf16_t*)(ws + WS_P0), (const bf16_t*)(ws + WS_P2), nullptr}; pg8::gemm_phase<EpiGate<false>, pg8::StaticOrder, false>(lds, g, S, E, nullptr); }
#endif
        __syncthreads();
        RELOAD();
#ifndef NO_B2
        { unsigned char* ws = p->ws;
          pg8::Gemm g{(const bf16_t*)(ws + WS_XN) + (size_t)MTOK * 512, (const bf16_t*)(ws + WS_W + (size_t)l * SZ_WL + SZ_WIN + SZ_WB), MTOK, DM, 512}; pg8::StaticOrder S; S.init(MTOK, DM, (int)gridDim.x, (int)blockIdx.x);
          EpiGate<true> E{(bf16_t*)(ws + WS_P1), (const bf16_t*)(ws + WS_P2) + 1024, (const bf16_t*)(ws + WS_P0)}; pg8::gemm_phase<EpiGate<true>, pg8::StaticOrder, false>(lds, g, S, E, nullptr); }
#endif
        grid.sync();
        RELOAD();
#ifndef NO_O
        { unsigned char* ws = p->ws;
          pg8::Gemm g{(const bf16_t*)(ws + WS_P1), (const bf16_t*)(ws + WS_W + (size_t)l * SZ_WL + SZ_WIN + 2 * SZ_WB), MTOK, DM, DM}; pg8::StaticOrder S; S.init(MTOK, DM, (int)gridDim.x, (int)blockIdx.x);
          EpiRes E{l == 0 ? p->x : (const float*)p->out, p->out}; pg8::gemm_phase<EpiRes, pg8::StaticOrder, false>(lds, g, S, E, nullptr); }
#endif
        grid.sync();
        RELOAD();
#ifndef NO_N
        if (l + 1 < DEPTH) { phase_norm(p, l + 1, p->out, (LAS float*)lds); grid.sync(); }
#endif
    }
    RELOAD();
#ifndef NO_F
    phase_final(p);
#endif
}

extern "C" void kernel_launch(void* const* d_in, const int* in_sizes, int n_in, void* d_out, int out_size, void* d_ws, size_t ws_size, hipStream_t stream) {
    static int grid = 0;
    if (grid == 0) {
        if (n_in != 12 || out_size != MTOK * DM || ws_size < WS_END) { fprintf(stderr, "kernel_launch: unexpected shapes (n_in %d out %d ws %zu, need %zu); nothing launched\n", n_in, out_size, ws_size, (size_t)WS_END); grid = -1; return; }
        int dev = 0, cus = 0, per_cu = 0;
        if (hipGetDevice(&dev) != hipSuccess || hipDeviceGetAttribute(&cus, hipDeviceAttributeMultiprocessorCount, dev) != hipSuccess) { grid = -1; return; }
        if (hipFuncSetAttribute((const void*)fwd_kernel, hipFuncAttributeMaxDynamicSharedMemorySize, LDS_BYTES) != hipSuccess) { fprintf(stderr, "kernel_launch: hipFuncSetAttribute failed\n"); grid = -1; return; }
        if (hipOccupancyMaxActiveBlocksPerMultiprocessor(&per_cu, (const void*)fwd_kernel, 512, LDS_BYTES) != hipSuccess || per_cu < 1) { fprintf(stderr, "kernel_launch: occupancy query says %d\n", per_cu); per_cu = 1; }
        (void)hipGetLastError();
        grid = cus;
    }
    if (grid < 0) return;
    Params p{};
    p.x = (const float*)d_in[0]; p.norm_w = (const float*)d_in[1]; p.w_in = (const float*)d_in[2]; p.conv_w = (const float*)d_in[3]; p.a_log = (const float*)d_in[4]; p.dt_bias = (const float*)d_in[5];
    p.gdn_norm_w = (const float*)d_in[6]; p.hg_lb = (const float*)d_in[7]; p.hg_norm_w = (const float*)d_in[8]; p.w_branch = (const float*)d_in[9]; p.w_out = (const float*)d_in[10]; p.final_norm_w = (const float*)d_in[11];
    p.out = (float*)d_out; p.ws = (unsigned char*)d_ws;
    void* args[] = {&p};
    hipError_t e = hipLaunchCooperativeKernel((const void*)fwd_kernel, dim3(grid), dim3(512), args, LDS_BYTES, stream);
    if (e != hipSuccess) fprintf(stderr, "kernel_launch: cooperative launch failed: %s (grid %d)\n", hipGetErrorString(e), grid);
}
```

```cpp
#include <hip/hip_runtime.h>
#include <hip/hip_cooperative_groups.h>
#include <cstdio>
namespace cg = cooperative_groups;
namespace pg8 {
#define PG8_LAS __attribute__((address_space(3)))
typedef unsigned short bf16_t;
typedef short bf16x8 __attribute__((ext_vector_type(8)));
typedef float f32x4 __attribute__((ext_vector_type(4)));
typedef unsigned u32x4 __attribute__((ext_vector_type(4)));
constexpr int BM = 256, BK = 64, HALF = 128, HTB = HALF * BK * 2  , STAGE_BYTES = 8 * HTB, NXCD = 8, WGM = 8;

__host__ __device__ __forceinline__ int lds_byte(int r, int c) { const int st = (r >> 4) * 2 + (c >> 5), rr = r & 15, cc = c & 31, ob = rr * 64 + cc * 2; return st * 1024 + (ob ^ (((ob >> 9) & 1) << 5)); }
__host__ __device__ __forceinline__ void stage_rc(int b, int& R, int& C) { const int st = b / 1024, sb = b % 1024, swz = sb ^ (((sb >> 9) & 1) << 5); R = (st >> 1) * 16 + swz / 64; C = (st & 1) * 32 + (swz % 64) / 2; }
__host__ __device__ __forceinline__ int perm32(int rho) { const int n = rho >> 4, i = rho & 15; return 8 * (i >> 2) + 4 * n + (i & 3); }

struct Unit { int pm, pn; };
struct Gemm { const bf16_t* A; const bf16_t* Bt; int M, N, K; };

struct StaticOrder {
    int nM, nN, nwg, G, c;
    __host__ __device__ void init(int M, int N, int G_, int c_) { nM = M / BM; nN = N / BM; nwg = nM * nN; G = G_; c = c_; }
    __host__ __device__ bool next(int i, Unit& u) const {
        const long L = (long)i * G + c; if (L >= nwg) return false;
        int wgid = (int)L; { const int q = nwg / NXCD, r = nwg % NXCD, xcd = wgid % NXCD, off = wgid / NXCD; wgid = (xcd < r ? xcd * (q + 1) : r * (q + 1) + (xcd - r) * q) + off; }
        const int nig = WGM * nN, gid = wgid / nig, fm = gid * WGM, gsz = (nM - fm) < WGM ? (nM - fm) : WGM;
        u.pm = fm + ((wgid % nig) % gsz); u.pn = (wgid % nig) / gsz; return true;
    }
    __device__ __forceinline__ void a_ready(const Unit&) const {}
    __device__ __forceinline__ void done(const Unit&) const {}
};
__device__ __forceinline__ unsigned cvt_pk_bf16(float lo, float hi) { unsigned r; asm volatile("v_cvt_pk_bf16_f32 %0, %1, %2" : "=v"(r) : "v"(lo), "v"(hi)); return r; }
typedef float f32x2 __attribute__((ext_vector_type(2)));
template <class Epi, class Sched, bool STAMP = false>
__device__ __forceinline__ void gemm_phase(PG8_LAS unsigned char* lds, const Gemm g, const Sched& S, const Epi& E, unsigned long long* stamps) {
    int tid_ = threadIdx.x; asm volatile("" : "+v"(tid_));
    const int tid = tid_, wid = __builtin_amdgcn_readfirstlane(tid >> 6), lane = tid & 63, wr = wid >> 2, wc = wid & 3, fr = lane & 15, fq = lane >> 4;
    const int K = g.K, nt = K / BK;
#define PG8_STAMP() do {} while (0)
    PG8_STAMP();
    unsigned voffA[2], voffB[2];
#pragma unroll
    for (int i = 0; i < 2; ++i) { int R, C; stage_rc(tid * 16 + i * 8192, R, C); const int Rb = Epi::PERM ? ((R & ~31) + perm32(R & 31)) : R;
        voffA[i] = (unsigned)(R * K + C) * 2u; voffB[i] = (unsigned)(Rb * K + C) * 2u; }
    const size_t kstep = (size_t)(BK * 2);
    const size_t hstep = (size_t)HALF * K * 2;
    const size_t tstep = 2 * hstep;
    const unsigned ldsw = (unsigned)wid * 1024u;
    const int aoff = lds_byte(wr * 64 + fr, fq * 8), boff = lds_byte(wc * 32 + fr, fq * 8);
#define PG8_SA(b, h) (((b) * 2 + (h)) * HTB)
#define PG8_SB(b, h) ((4 + (b) * 2 + (h)) * HTB)
#define PG8_STAGE(bufoff, gbase, voff) do { _Pragma("unroll") for (int _i = 0; _i < 2; ++_i) \
        __builtin_amdgcn_global_load_lds((const unsigned*)((const char*)(gbase) + (voff)[_i]), (PG8_LAS unsigned*)(lds + (bufoff) + ldsw + _i * 8192), 16, 0, 0); } while (0)
#define PG8_LDA(dst, b, h) do { _Pragma("unroll") for (int m = 0; m < 4; ++m) _Pragma("unroll") for (int k = 0; k < 2; ++k) dst[m][k] = *(const PG8_LAS bf16x8*)(lds + PG8_SA(b, h) + aoff + m * 2048 + k * 1024); } while (0)
#define PG8_LDB(dst, b, h) do { _Pragma("unroll") for (int n = 0; n < 2; ++n) _Pragma("unroll") for (int k = 0; k < 2; ++k) dst[n][k] = *(const PG8_LAS bf16x8*)(lds + PG8_SB(b, h) + boff + n * 2048 + k * 1024); } while (0)
#define PG8_MMA(ai, bj, At, Bt) do { __builtin_amdgcn_s_setprio(1); _Pragma("unroll") for (int m = 0; m < 4; ++m) _Pragma("unroll") for (int n = 0; n < 2; ++n) _Pragma("unroll") for (int k = 0; k < 2; ++k) \
        acc[ai][bj][m][n] = __builtin_amdgcn_mfma_f32_16x16x32_bf16(Bt[n][k], At[m][k], acc[ai][bj][m][n], 0, 0, 0); __builtin_amdgcn_s_setprio(0); } while (0)
#define PG8_WAIT_V(n) asm volatile("s_waitcnt vmcnt(" #n ")" ::: "memory")
#define PG8_WAIT_L(n) asm volatile("s_waitcnt lgkmcnt(" #n ")" ::: "memory")
#define PG8_BAR __builtin_amdgcn_s_barrier()
#define PG8_SCHED __builtin_amdgcn_sched_barrier(0)
    Unit cur, nxt; int ui = 0;
    if (!S.next(0, cur)) return;
    f32x4 acc[2][2][4][2];
#pragma unroll
    for (int a = 0; a < 2; ++a)
#pragma unroll
        for (int b = 0; b < 2; ++b)
#pragma unroll
            for (int m = 0; m < 4; ++m)
#pragma unroll
                for (int n = 0; n < 2; ++n) acc[a][b][m][n] = (f32x4){0.f, 0.f, 0.f, 0.f};
    bf16x8 At[4][2], B0[2][2], B1[2][2];
    const char* cA = (const char*)g.A + (size_t)cur.pm * tstep; const char* cB = (const char*)g.Bt + (size_t)cur.pn * tstep;
    S.a_ready(cur);
    PG8_STAGE(PG8_SB(0, 0), cB, voffB); PG8_STAGE(PG8_SA(0, 0), cA, voffA); PG8_STAGE(PG8_SB(0, 1), cB + hstep, voffB); PG8_STAGE(PG8_SA(0, 1), cA + hstep, voffA);
    if (wr == 1) PG8_BAR;
    PG8_WAIT_V(4); PG8_BAR;
    PG8_STAGE(PG8_SB(1, 0), cB + kstep, voffB); PG8_STAGE(PG8_SA(1, 0), cA + kstep, voffA); PG8_STAGE(PG8_SB(1, 1), cB + hstep + kstep, voffB);
    PG8_WAIT_V(6); PG8_BAR;
    PG8_STAMP();
    for (;;) {
        const bool has_next = S.next(ui + 1, nxt);
        const char* nA = has_next ? (const char*)g.A + (size_t)nxt.pm * tstep : cA; const char* nB = has_next ? (const char*)g.Bt + (size_t)nxt.pn * tstep : cB;
        for (int t = 0; t < nt; t += 2) {
            const bool last = (t == nt - 2);
            const char* a1 = cA + (size_t)(t + 1) * kstep;
            const char* a2 = last ? nA : cA + (size_t)(t + 2) * kstep; const char* b2 = last ? nB : cB + (size_t)(t + 2) * kstep;
            const char* a3 = a2 + kstep; const char* b3 = b2 + kstep;
            if (last && has_next) S.a_ready(nxt);
            PG8_LDB(B0, 0, 0); PG8_SCHED; PG8_LDA(At, 0, 0); PG8_STAGE(PG8_SA(1, 1), a1 + hstep, voffA);
            PG8_WAIT_L(8); PG8_BAR; PG8_WAIT_L(0); PG8_MMA(0, 0, At, B0); PG8_BAR; PG8_SCHED;
            PG8_LDB(B1, 0, 1); PG8_STAGE(PG8_SB(0, 0), b2, voffB);
            PG8_BAR; PG8_WAIT_L(0); PG8_MMA(0, 1, At, B1); PG8_BAR;
            PG8_LDA(At, 0, 1); PG8_STAGE(PG8_SA(0, 0), a2, voffA);
            PG8_BAR; PG8_WAIT_L(0); PG8_MMA(1, 0, At, B0); PG8_BAR; PG8_SCHED;
            PG8_STAGE(PG8_SB(0, 1), b2 + hstep, voffB);
            PG8_WAIT_V(6); PG8_BAR; PG8_MMA(1, 1, At, B1); PG8_BAR;
            PG8_LDB(B0, 1, 0); PG8_SCHED; PG8_LDA(At, 1, 0); PG8_STAGE(PG8_SA(0, 1), a2 + hstep, voffA);
            PG8_WAIT_L(8); PG8_BAR; PG8_WAIT_L(0); PG8_MMA(0, 0, At, B0); PG8_BAR; PG8_SCHED;
            PG8_LDB(B1, 1, 1); PG8_STAGE(PG8_SB(1, 0), b3, voffB);
            PG8_BAR; PG8_WAIT_L(0); PG8_MMA(0, 1, At, B1); PG8_BAR;
            PG8_LDA(At, 1, 1); PG8_STAGE(PG8_SA(1, 0), a3, voffA);
            PG8_BAR; PG8_WAIT_L(0); PG8_MMA(1, 0, At, B0); PG8_BAR; PG8_SCHED;
            PG8_STAGE(PG8_SB(1, 1), b3 + hstep, voffB);
            PG8_WAIT_V(6); PG8_BAR; PG8_MMA(1, 1, At, B1); PG8_BAR;
        }
        PG8_STAMP();
        if constexpr (!Epi::AFTER_DRAIN) { E(acc, cur, wr, wc, fr, fq); S.done(cur); }
        PG8_STAMP();
        if (!has_next) break;
#pragma unroll
        for (int a = 0; a < 2; ++a)
#pragma unroll
            for (int b = 0; b < 2; ++b)
#pragma unroll
                for (int m = 0; m < 4; ++m)
#pragma unroll
                    for (int n = 0; n < 2; ++n) acc[a][b][m][n] = (f32x4){0.f, 0.f, 0.f, 0.f};
        cur = nxt; cA = nA; cB = nB; ++ui;
    }
    PG8_WAIT_V(0);
    if (wr == 0) PG8_BAR;
    PG8_BAR;
    if constexpr (Epi::AFTER_DRAIN) { E.fused(acc, cur, wr, wc, fr, fq, lds, wid, lane); S.done(cur); }
    PG8_STAMP();
#undef PG8_STAMP
#undef PG8_SA
#undef PG8_SB
#undef PG8_STAGE
#undef PG8_LDA
#undef PG8_LDB
#undef PG8_MMA
#undef PG8_WAIT_V
#undef PG8_WAIT_L
#undef PG8_BAR
#undef PG8_SCHED
}
}

using pg8::bf16_t; using pg8::f32x4; using pg8::u32x4;
typedef float f32x2v __attribute__((ext_vector_type(2)));
#define LAS __attribute__((address_space(3)))
constexpr int DM = 1024, NB = 16, SEQ = 4096, MTOK = NB * SEQ, DEPTH = 2, INC = 6152, NPROJ = 6144, PW = 2048;
constexpr float EPS = 1e-6f;
constexpr int LDS_BYTES = 131072;
constexpr size_t SZ_P = (size_t)MTOK * PW * 2;
constexpr size_t WS_P0 = 0, WS_P1 = SZ_P, WS_P2 = 2 * SZ_P, WS_XN = 3 * SZ_P;
constexpr size_t SZ_XN = (size_t)MTOK * DM * 2;
constexpr size_t WS_W = WS_XN + SZ_XN;
constexpr size_t SZ_WIN = (size_t)NPROJ * DM * 2, SZ_WB = (size_t)DM * 512 * 2, SZ_WO = (size_t)DM * DM * 2;
constexpr size_t SZ_WL = SZ_WIN + 2 * SZ_WB + SZ_WO;
constexpr size_t WS_G = WS_W + DEPTH * SZ_WL;
constexpr size_t SZ_G = (size_t)MTOK * 4 * 4;
constexpr size_t WS_BETA = WS_G + SZ_G;
constexpr size_t WS_END = WS_BETA + SZ_G;

struct Params {
    const float* x; const float* norm_w; const float* w_in; const float* conv_w; const float* a_log; const float* dt_bias;
    const float* gdn_norm_w; const float* hg_lb; const float* hg_norm_w; const float* w_branch; const float* w_out; const float* final_norm_w;
    float* out; unsigned char* ws;
};

typedef const __attribute__((address_space(4))) Params* KP;
__device__ __forceinline__ float bflo(unsigned u) { return __uint_as_float(u << 16); }
__device__ __forceinline__ float bfhi(unsigned u) { return __uint_as_float(u & 0xffff0000u); }
__device__ __forceinline__ bf16_t f2bf(float f) { unsigned u = __float_as_uint(f); u += 0x7FFFu + ((u >> 16) & 1u); return (bf16_t)(u >> 16); }
__device__ __forceinline__ float sigm(float x) { return 1.f / (1.f + __expf(-x)); }
__device__ __forceinline__ float silu(float x) { return x / (1.f + __expf(-x)); }
__device__ __forceinline__ void unpack8(const uint4 u, float (&f)[8]) { f[0] = bflo(u.x); f[1] = bfhi(u.x); f[2] = bflo(u.y); f[3] = bfhi(u.y); f[4] = bflo(u.z); f[5] = bfhi(u.z); f[6] = bflo(u.w); f[7] = bfhi(u.w); }
__device__ __forceinline__ uint4 pack8(const float (&f)[8]) { uint4 u; u.x = pg8::cvt_pk_bf16(f[0], f[1]); u.y = pg8::cvt_pk_bf16(f[2], f[3]); u.z = pg8::cvt_pk_bf16(f[4], f[5]); u.w = pg8::cvt_pk_bf16(f[6], f[7]); return u; }
template <int CTRL> __device__ __forceinline__ float dppf(float x) { return __int_as_float(__builtin_amdgcn_update_dpp(0, __float_as_int(x), CTRL, 0xf, 0xf, true)); }
__device__ __forceinline__ float sum8(float x) { x += dppf<0xB1>(x); x += dppf<0x4E>(x); x += dppf<0x141>(x); return x; }
__device__ __forceinline__ float sum16(float x) { x = sum8(x); x += dppf<0x140>(x); return x; }
__device__ __forceinline__ float sum64(float x) { x = sum16(x); x += __shfl_xor(x, 16); x += __shfl_xor(x, 32); return x; }

struct EpiSplit {
    static constexpr bool PERM = true, AFTER_DRAIN = false;
    bf16_t* O;
    __device__ __forceinline__ void operator()(const f32x4 (&acc)[2][2][4][2], const pg8::Unit& u, int wr, int wc, int fr, int fq) const {
        const int row0 = u.pm * 256 + wr * 64 + fr; int colt = u.pn * 256; const int t = colt / PW; colt -= t * PW;
        bf16_t* base = O + (size_t)t * MTOK * PW; const int col0 = colt + wc * 32 + 8 * fq;
#pragma unroll
        for (int ai = 0; ai < 2; ++ai)
#pragma unroll
            for (int m = 0; m < 4; ++m) { bf16_t* rowp = base + (size_t)(row0 + ai * 128 + m * 16) * PW + col0;
#pragma unroll
                for (int bj = 0; bj < 2; ++bj) { const f32x4 v0 = acc[ai][bj][m][0], v1 = acc[ai][bj][m][1];
                    u32x4 w; w.x = pg8::cvt_pk_bf16(v0[0], v0[1]); w.y = pg8::cvt_pk_bf16(v0[2], v0[3]); w.z = pg8::cvt_pk_bf16(v1[0], v1[1]); w.w = pg8::cvt_pk_bf16(v1[2], v1[3]);
                    *(u32x4*)(rowp + bj * 128) = w; } }
    }
};
template <bool ADD> struct EpiGate {
    static constexpr bool PERM = true, AFTER_DRAIN = false;
    bf16_t* O; const bf16_t* gate; const bf16_t* addsrc;
    __device__ __forceinline__ void operator()(const f32x4 (&acc)[2][2][4][2], const pg8::Unit& u, int wr, int wc, int fr, int fq) const {
        const int row0 = u.pm * 256 + wr * 64 + fr; const int col0 = u.pn * 256 + wc * 32 + 8 * fq;
#pragma unroll
        for (int ai = 0; ai < 2; ++ai)
#pragma unroll
            for (int m = 0; m < 4; ++m) { const size_t r = (size_t)(row0 + ai * 128 + m * 16);
#pragma unroll
                for (int bj = 0; bj < 2; ++bj) { const int c = col0 + bj * 128;
                    const uint4 gu = *(const uint4*)(gate + r * PW + c); float gf[8]; unpack8(gu, gf);
                    const f32x4 v0 = acc[ai][bj][m][0], v1 = acc[ai][bj][m][1];
                    float v[8] = {v0[0], v0[1], v0[2], v0[3], v1[0], v1[1], v1[2], v1[3]};
#pragma unroll
                    for (int j = 0; j < 8; ++j) v[j] *= sigm(gf[j]);
                    if (ADD) { const uint4 au = *(const uint4*)(addsrc + r * DM + c); float af[8]; unpack8(au, af);
#pragma unroll
                        for (int j = 0; j < 8; ++j) v[j] += af[j]; }
                    *(uint4*)(O + r * DM + c) = pack8(v); } }
    }
};
struct EpiRes {
    static constexpr bool PERM = false, AFTER_DRAIN = false;
    const float* base; float* out;
    __device__ __forceinline__ void operator()(const f32x4 (&acc)[2][2][4][2], const pg8::Unit& u, int wr, int wc, int fr, int fq) const {
        const int row0 = u.pm * 256 + wr * 64 + fr, col0 = u.pn * 256 + wc * 32 + 4 * fq;
#pragma unroll
        for (int ai = 0; ai < 2; ++ai)
#pragma unroll
            for (int m = 0; m < 4; ++m) { const size_t off = (size_t)(row0 + ai * 128 + m * 16) * DM + col0;
#pragma unroll
                for (int bj = 0; bj < 2; ++bj)
#pragma unroll
                    for (int n = 0; n < 2; ++n) { const size_t o2 = off + bj * 128 + n * 16; *(f32x4*)(out + o2) = *(const f32x4*)(base + o2) + acc[ai][bj][m][n]; } }
    }
};

__device__ void convT(const float* src, int ld, int col0, int N, int K, bf16_t* dst, LAS float* tile) {
    const int tid = threadIdx.x; const int ntn = N / 64, ntk = K / 64;
    for (int t = blockIdx.x; t < ntn * ntk; t += gridDim.x) {
        const int n0 = (t % ntn) * 64, k0 = (t / ntn) * 64;
        { const int kk = tid >> 6, nn = tid & 63;
#pragma unroll
          for (int i = 0; i < 8; ++i) tile[(kk + 8 * i) * 65 + nn] = src[(size_t)(k0 + kk + 8 * i) * ld + col0 + n0 + nn]; }
        __syncthreads();
        { const int nn = tid >> 6, kk = tid & 63;
#pragma unroll
          for (int i = 0; i < 8; ++i) dst[(size_t)(n0 + nn + 8 * i) * K + k0 + kk] = f2bf(tile[kk * 65 + nn + 8 * i]); }
        __syncthreads();
    }
}
__device__ void phase_weights(KP p, LAS float* tile) {
    for (int l = 0; l < DEPTH; ++l) {
        unsigned char* wl = p->ws + WS_W + (size_t)l * SZ_WL;
        const float* win = p->w_in + (size_t)l * DM * INC;
        convT(win, INC, 0, 1536, DM, (bf16_t*)wl, tile);
        convT(win, INC, 1544, NPROJ - 1536, DM, (bf16_t*)wl + (size_t)1536 * DM, tile);
        convT(p->w_branch + (size_t)(l * 2 + 0) * 512 * DM, DM, 0, DM, 512, (bf16_t*)(wl + SZ_WIN), tile);
        convT(p->w_branch + (size_t)(l * 2 + 1) * 512 * DM, DM, 0, DM, 512, (bf16_t*)(wl + SZ_WIN + SZ_WB), tile);
        convT(p->w_out + (size_t)l * DM * DM, DM, 0, DM, DM, (bf16_t*)(wl + SZ_WIN + 2 * SZ_WB), tile);
    }
}

__device__ void phase_norm(KP p, int l, const float* hsrc, LAS float* wab) {
    const int tid = threadIdx.x, lane = tid & 63, wave = tid >> 6;
    const float* win = p->w_in + (size_t)l * DM * INC;
    __syncthreads();
    for (int i = tid; i < 8192; i += 512) { const int k = i >> 3, j = i & 7; wab[j * 1024 + k] = win[(size_t)k * INC + 1536 + j]; }
    __syncthreads();
    const float* nw = p->norm_w + l * DM;
    bf16_t* XN = (bf16_t*)(p->ws + WS_XN); float* G = (float*)(p->ws + WS_G); float* BT = (float*)(p->ws + WS_BETA);
    float4 nwv[4];
#pragma unroll
    for (int c = 0; c < 4; ++c) nwv[c] = *(const float4*)(nw + c * 256 + lane * 4);
    const float alog = p->a_log[l * 4 + (lane & 3)], dtb = p->dt_bias[l * 4 + (lane & 3)];
    for (int row = blockIdx.x * 8 + wave; row < MTOK; row += gridDim.x * 8) {
        const float* hr = hsrc + (size_t)row * DM;
        float4 v[4]; float ss = 0.f;
#pragma unroll
        for (int c = 0; c < 4; ++c) { v[c] = *(const float4*)(hr + c * 256 + lane * 4); ss += v[c].x * v[c].x + v[c].y * v[c].y + v[c].z * v[c].z + v[c].w * v[c].w; }
        ss = sum64(ss);
        const float rstd = rsqrtf(ss * (1.f / DM) + EPS);
        float acc[8];
#pragma unroll
        for (int j = 0; j < 8; ++j) acc[j] = 0.f;
#pragma unroll
        for (int c = 0; c < 4; ++c) {
            const float x0 = v[c].x * rstd * nwv[c].x, x1 = v[c].y * rstd * nwv[c].y, x2 = v[c].z * rstd * nwv[c].z, x3 = v[c].w * rstd * nwv[c].w;
            uint2 pk; pk.x = pg8::cvt_pk_bf16(x0, x1); pk.y = pg8::cvt_pk_bf16(x2, x3);
            *(uint2*)(XN + (size_t)row * DM + c * 256 + lane * 4) = pk;
#pragma unroll
            for (int j = 0; j < 8; ++j) { const f32x4 w = *(const LAS f32x4*)(wab + j * 1024 + c * 256 + lane * 4); acc[j] += x0 * w[0] + x1 * w[1] + x2 * w[2] + x3 * w[3]; }
        }
#pragma unroll
        for (int j = 0; j < 8; ++j) acc[j] = sum64(acc[j]);
        if (lane < 4) {
            const float a = lane == 0 ? acc[0] : lane == 1 ? acc[1] : lane == 2 ? acc[2] : acc[3];
            const float bb = lane == 0 ? acc[4] : lane == 1 ? acc[5] : lane == 2 ? acc[6] : acc[7];
            const float z = a + dtb; const float sp = z > 20.f ? z : log1pf(expf(z));
            G[(size_t)row * 4 + lane] = -expf(alog) * sp;
            BT[(size_t)row * 4 + lane] = 1.f / (1.f + expf(-bb));
        }
    }
}

typedef short s16x4 __attribute__((ext_vector_type(4)));
typedef __bf16 bf16x2_t __attribute__((ext_vector_type(2)));
typedef unsigned u32x2v __attribute__((ext_vector_type(2)));
__device__ __forceinline__ unsigned cvt2(float lo, float hi) { f32x2v v = {lo, hi}; bf16x2_t r = __builtin_convertvector(v, bf16x2_t); return __builtin_bit_cast(unsigned, r); }
__device__ __forceinline__ s16x4 cvt4(f32x4 v) { u32x2v u = {cvt2(v[0], v[1]), cvt2(v[2], v[3])}; return __builtin_bit_cast(s16x4, u); }
#define MFMA16(a, b, c) __builtin_amdgcn_mfma_f32_16x16x16bf16_1k((a), (b), (c), 0, 0, 0)

__device__ void gdn_tokenrec(KP p, int l, int idx, LAS float* lds) {
    int tid_ = threadIdx.x; asm volatile("" : "+v"(tid_));
    const int tid = tid_, lane = tid & 63, wave = tid >> 6;
    LAS float* sq = lds; LAS float* sk = lds + 8192; LAS float* sv = lds + 16384; LAS float* so = lds + 20480;
    LAS float* seg = lds + 24576; LAS float* sbe = seg + 64; LAS float* scw = seg + 128;
    const float* G = (const float*)(p->ws + WS_G); const float* BT = (const float*)(p->ws + WS_BETA);
    bf16_t* OUT = (bf16_t*)(p->ws + WS_XN);
    const int r = lane & 15, cp = wave * 4 + (lane >> 4);
    const int tok = tid >> 3, sub = tid & 7;
    const int b = idx >> 3, h = (idx >> 1) & 3, half = idx & 1;
    __syncthreads();
    for (int i = tid; i < 1280; i += 512) { const int j = i / 320, cc = i % 320;
        const int ch = cc < 128 ? h * 128 + cc : (cc < 256 ? 512 + h * 128 + (cc - 128) : 1024 + h * 128 + half * 64 + (cc - 256));
        scw[i] = p->conv_w[(size_t)(l * 4 + j) * 1536 + ch]; }
    float S[8][2];
#pragma unroll
    for (int i = 0; i < 8; ++i) { S[i][0] = 0.f; S[i][1] = 0.f; }
    const bf16_t* PB = (const bf16_t*)(p->ws + WS_P0);
    for (int ck = 0; ck < SEQ / 64; ++ck) {
        __syncthreads();
        const int s = ck * 64 + tok; const size_t rowg = (size_t)b * SEQ + s;
        {
            float qv[16], kv[16], vv[8];
#pragma unroll
            for (int i = 0; i < 16; ++i) { qv[i] = 0.f; kv[i] = 0.f; }
#pragma unroll
            for (int i = 0; i < 8; ++i) vv[i] = 0.f;
#pragma unroll
            for (int j = 0; j < 4; ++j) {
                if (s - 3 + j >= 0) {
                    const bf16_t* rp = PB + (rowg - 3 + j) * PW;
                    float t8[8];
                    LAS float* cw = scw + j * 320;
                    unpack8(*(const uint4*)(rp + h * 128 + sub * 16), t8);
#pragma unroll
                    for (int i = 0; i < 8; ++i) qv[i] += t8[i] * cw[sub * 16 + i];
                    unpack8(*(const uint4*)(rp + h * 128 + sub * 16 + 8), t8);
#pragma unroll
                    for (int i = 0; i < 8; ++i) qv[8 + i] += t8[i] * cw[sub * 16 + 8 + i];
                    unpack8(*(const uint4*)(rp + 512 + h * 128 + sub * 16), t8);
#pragma unroll
                    for (int i = 0; i < 8; ++i) kv[i] += t8[i] * cw[128 + sub * 16 + i];
                    unpack8(*(const uint4*)(rp + 512 + h * 128 + sub * 16 + 8), t8);
#pragma unroll
                    for (int i = 0; i < 8; ++i) kv[8 + i] += t8[i] * cw[128 + sub * 16 + 8 + i];
                    unpack8(*(const uint4*)(rp + 1024 + h * 128 + half * 64 + sub * 8), t8);
#pragma unroll
                    for (int i = 0; i < 8; ++i) vv[i] += t8[i] * cw[256 + sub * 8 + i];
                }
            }
            float sqq = 0.f, skk = 0.f;
#pragma unroll
            for (int i = 0; i < 16; ++i) { qv[i] = silu(qv[i]); kv[i] = silu(kv[i]); sqq += qv[i] * qv[i]; skk += kv[i] * kv[i]; }
#pragma unroll
            for (int i = 0; i < 8; ++i) vv[i] = silu(vv[i]);
            sqq = sum8(sqq); skk = sum8(skk);
            const float rq = rsqrtf(sqq + EPS) * 0.08838834764831845f, rk = rsqrtf(skk + EPS);
#pragma unroll
            for (int i = 0; i < 16; ++i) { sq[tok * 128 + sub * 16 + i] = qv[i] * rq; sk[tok * 128 + sub * 16 + i] = kv[i] * rk; }
#pragma unroll
            for (int i = 0; i < 8; ++i) sv[tok * 64 + sub * 8 + i] = vv[i];
            if (sub == 0) { seg[tok] = __expf(G[rowg * 4 + h]); sbe[tok] = BT[rowg * 4 + h]; }
        }
        __syncthreads();
        for (int t = 0; t < 64; ++t) {
            const f32x4 k0 = *(const LAS f32x4*)(sk + t * 128 + r * 8), k1 = *(const LAS f32x4*)(sk + t * 128 + r * 8 + 4);
            const f32x4 q0 = *(const LAS f32x4*)(sq + t * 128 + r * 8), q1 = *(const LAS f32x4*)(sq + t * 128 + r * 8 + 4);
            const f32x2v v2 = *(const LAS f32x2v*)(sv + t * 64 + cp * 2);
            const float eg = seg[t], be = sbe[t];
            const float kk[8] = {k0[0], k0[1], k0[2], k0[3], k1[0], k1[1], k1[2], k1[3]};
            const float qq[8] = {q0[0], q0[1], q0[2], q0[3], q1[0], q1[1], q1[2], q1[3]};
            float p0 = 0.f, p1 = 0.f;
#pragma unroll
            for (int i = 0; i < 8; ++i) { p0 += kk[i] * S[i][0]; p1 += kk[i] * S[i][1]; }
            p0 = sum16(p0); p1 = sum16(p1);
            const float d0 = be * (v2[0] - eg * p0), d1 = be * (v2[1] - eg * p1);
            float o0 = 0.f, o1 = 0.f;
#pragma unroll
            for (int i = 0; i < 8; ++i) { S[i][0] = eg * S[i][0] + kk[i] * d0; S[i][1] = eg * S[i][1] + kk[i] * d1; o0 += qq[i] * S[i][0]; o1 += qq[i] * S[i][1]; }
            o0 = sum16(o0); o1 = sum16(o1);
            if (r == 0) *(LAS f32x2v*)(so + t * 64 + cp * 2) = (f32x2v){o0, o1};
        }
        __syncthreads();
        { float o8[8];
#pragma unroll
          for (int i = 0; i < 8; ++i) o8[i] = so[tok * 64 + sub * 8 + i];
          *(uint4*)(OUT + rowg * 512 + h * 128 + half * 64 + sub * 8) = pack8(o8); }
    }
}

__device__ void hgrn_chunk(KP p, int l, int idx, LAS unsigned char* lds) {
    int tid_ = threadIdx.x; asm volatile("" : "+v"(tid_));
    const int tid = tid_, lane = tid & 63, wave = __builtin_amdgcn_readfirstlane(tid >> 6), g = lane >> 4, r16 = lane & 15;
    LAS unsigned char* QT = lds;
    LAS unsigned char* KT = lds + 16896;
    LAS unsigned char* KDT = lds + 33792;
    LAS unsigned char* VT = lds + 52224;
    LAS float* GL = (LAS float*)(lds + 70656);
    LAS unsigned char* AQ = lds + 72704;
    LAS float* OB = (LAS float*)(lds + 75264);
    LAS float* SLB = (LAS float*)(lds + 109056);
    const int b = idx >> 2, h = idx & 3;
    const bf16_t* P1 = (const bf16_t*)(p->ws + WS_P1);
    bf16_t* YB = (bf16_t*)(p->ws + WS_XN) + (size_t)MTOK * 512;
    __syncthreads();
    if (tid < 128) { const int c = h * 128 + tid; float mx = -1e30f;
        for (int i = 0; i < DEPTH; ++i) mx = fmaxf(mx, p->hg_lb[i * 512 + c]);
        float den = 0.f, num = 0.f;
        for (int i = 0; i < DEPTH; ++i) { const float e = expf(p->hg_lb[i * 512 + c] - mx); den += e; if (i >= 1 && i <= l) num += e; }
        SLB[tid] = num / den; }
    __syncthreads();
    const int sc_c = tid & 127, sc_cc = tid >> 7;
    const float lb = SLB[sc_c];
    const int tok = tid >> 3, sub = tid & 7;
    const float* nwp = p->hg_norm_w + l * 128 + sub * 16;
    float nw[16];
#pragma unroll
    for (int i = 0; i < 16; ++i) nw[i] = nwp[i];
    f32x4 S[8];
#pragma unroll
    for (int t = 0; t < 8; ++t) S[t] = (f32x4){0.f, 0.f, 0.f, 0.f};
    for (int sc = 0; sc < SEQ / 64; ++sc) {
        __syncthreads();
        {
            const size_t row0 = (size_t)b * SEQ + sc * 64 + sc_cc * 16;
            const bf16_t* base = P1 + row0 * PW + h * 128 + sc_c;
            float f[16], q[16]; unsigned short vraw[16];
#pragma unroll
            for (int t = 0; t < 16; ++t) { q[t] = bflo((unsigned)base[(size_t)t * PW]); const float x = bflo((unsigned)base[(size_t)t * PW + 512]); f[t] = lb + (1.f - lb) * sigm(x); vraw[t] = base[(size_t)t * PW + 1024]; }
            float pre[16], suf[16]; float run = 1.f;
#pragma unroll
            for (int t = 0; t < 16; ++t) { run *= f[t]; pre[t] = run; }
            GL[sc_cc * 128 + sc_c] = run;
            run = 1.f;
#pragma unroll
            for (int t = 15; t >= 0; --t) { suf[t] = run; run *= f[t]; }
            float kd[16];
#pragma unroll
            for (int t = 0; t < 16; ++t) { const float k = 1.f - f[t]; const float ip = 1.f / fmaxf(pre[t], 1e-30f);
                *(LAS bf16_t*)(QT + (sc_cc * 16 + t) * 264 + sc_c * 2) = f2bf(q[t] * pre[t]);
                *(LAS bf16_t*)(KT + (sc_cc * 16 + t) * 264 + sc_c * 2) = f2bf(k * ip);
                kd[t] = k * suf[t]; }
            u32x4 w0, w1;
            w0.x = cvt2(kd[0], kd[1]); w0.y = cvt2(kd[2], kd[3]); w0.z = cvt2(kd[4], kd[5]); w0.w = cvt2(kd[6], kd[7]);
            w1.x = cvt2(kd[8], kd[9]); w1.y = cvt2(kd[10], kd[11]); w1.z = cvt2(kd[12], kd[13]); w1.w = cvt2(kd[14], kd[15]);
            *(LAS u32x4*)(KDT + sc_c * 144 + sc_cc * 32) = w0; *(LAS u32x4*)(KDT + sc_c * 144 + sc_cc * 32 + 16) = w1;
            w0.x = vraw[0] | ((unsigned)vraw[1] << 16); w0.y = vraw[2] | ((unsigned)vraw[3] << 16); w0.z = vraw[4] | ((unsigned)vraw[5] << 16); w0.w = vraw[6] | ((unsigned)vraw[7] << 16);
            w1.x = vraw[8] | ((unsigned)vraw[9] << 16); w1.y = vraw[10] | ((unsigned)vraw[11] << 16); w1.z = vraw[12] | ((unsigned)vraw[13] << 16); w1.w = vraw[14] | ((unsigned)vraw[15] << 16);
            *(LAS u32x4*)(VT + sc_c * 144 + sc_cc * 32) = w0; *(LAS u32x4*)(VT + sc_c * 144 + sc_cc * 32 + 16) = w1;
        }
        __syncthreads();
        if (wave < 4) {
            const int c = wave; f32x4 acc = (f32x4){0.f, 0.f, 0.f, 0.f};
#pragma unroll
            for (int kk = 0; kk < 8; ++kk) {
                const s16x4 a = *(const LAS s16x4*)(QT + (16 * c + r16) * 264 + (16 * kk + 4 * g) * 2);
                const s16x4 bb = *(const LAS s16x4*)(KT + (16 * c + r16) * 264 + (16 * kk + 4 * g) * 2);
                acc = MFMA16(a, bb, acc); }
#pragma unroll
            for (int j = 0; j < 4; ++j) { const float val = (r16 <= 4 * g + j) ? acc[j] : 0.f; *(LAS bf16_t*)(AQ + c * 640 + (4 * g + j) * 40 + r16 * 2) = f2bf(val); }
        }
        __syncthreads();
#pragma unroll 1
        for (int c = 0; c < 4; ++c) {
            const s16x4 bv = *(const LAS s16x4*)(VT + (16 * wave + r16) * 144 + (16 * c + 4 * g) * 2);
            f32x4 R = (f32x4){0.f, 0.f, 0.f, 0.f};
#pragma unroll
            for (int t = 0; t < 8; ++t) { const s16x4 a = *(const LAS s16x4*)(QT + (16 * c + r16) * 264 + (16 * t + 4 * g) * 2); R = MFMA16(a, cvt4(S[t]), R); }
            R = MFMA16(*(const LAS s16x4*)(AQ + c * 640 + r16 * 40 + 4 * g * 2), bv, R);
#pragma unroll
            for (int j = 0; j < 4; ++j) OB[(16 * c + 4 * g + j) * 132 + 16 * wave + r16] = R[j];
#pragma unroll
            for (int t = 0; t < 8; ++t) { const f32x4 gl4 = *(const LAS f32x4*)(GL + c * 128 + 16 * t + 4 * g);
                const s16x4 a = *(const LAS s16x4*)(KDT + (16 * t + r16) * 144 + (16 * c + 4 * g) * 2);
                S[t] = MFMA16(a, bv, S[t] * gl4); }
        }
        __syncthreads();
        {
            const size_t rowg = (size_t)b * SEQ + sc * 64 + tok;
            float o[16]; float ss = 0.f;
#pragma unroll
            for (int i = 0; i < 4; ++i) { const f32x4 v = *(const LAS f32x4*)(OB + tok * 132 + sub * 16 + 4 * i); o[4 * i] = v[0]; o[4 * i + 1] = v[1]; o[4 * i + 2] = v[2]; o[4 * i + 3] = v[3]; ss += v[0] * v[0] + v[1] * v[1] + v[2] * v[2] + v[3] * v[3]; }
            ss = sum8(ss);
            const float rstd = rsqrtf(ss * (1.f / 128.f) + EPS);
            const bf16_t* zp = P1 + rowg * PW + 1536 + h * 128 + sub * 16;
            float z0[8], z1[8]; unpack8(*(const uint4*)zp, z0); unpack8(*(const uint4*)(zp + 8), z1);
            float y0[8], y1[8];
#pragma unroll
            for (int i = 0; i < 8; ++i) { y0[i] = o[i] * rstd * nw[i] * silu(z0[i]); y1[i] = o[8 + i] * rstd * nw[8 + i] * silu(z1[i]); }
            bf16_t* yp = YB + rowg * 512 + h * 128 + sub * 16;
            *(uint4*)yp = pack8(y0); *(uint4*)(yp + 8) = pack8(y1);
        }
    }
}

#define TROW(row) ((row) * 144 + ((row) >> 4) * 8)
__device__ void gdn_chunk(KP p, int l, int idx, LAS unsigned char* lds) {
    int tid_ = threadIdx.x; asm volatile("" : "+v"(tid_));
    const int tid = tid_, lane = tid & 63, wave = __builtin_amdgcn_readfirstlane(tid >> 6), g = lane >> 4, r16 = lane & 15;
    LAS unsigned char* QB = lds;
    LAS unsigned char* KB = lds + 17408;
    LAS unsigned char* VBT = lds + 34816;
    LAS unsigned char* KGT = lds + 53312;
    LAS unsigned char* KDT = lds + 71808;
    LAS unsigned char* TM = lds + 90304;
    LAS unsigned char* AQ = lds + 92864;
    LAS float* AM = (LAS float*)(lds + 95424);
    LAS float* GC = (LAS float*)(lds + 100544);
    LAS float* EG = GC + 64; LAS float* EGD = GC + 128; LAS float* BE = GC + 192; LAS float* GLC = GC + 256;
    LAS float* CW = (LAS float*)(lds + 101632);
    LAS float* OB = (LAS float*)(lds + 34816);
    const int b = idx >> 2, h = idx & 3;
    const bf16_t* P0 = (const bf16_t*)(p->ws + WS_P0);
    const float* Gg = (const float*)(p->ws + WS_G); const float* BT = (const float*)(p->ws + WS_BETA);
    bf16_t* YA = (bf16_t*)(p->ws + WS_XN);
    __syncthreads();
    for (int i = tid; i < 1536; i += 512) { const int j = i / 384, cc = i % 384;
        const int ch = (cc >> 7) * 512 + h * 128 + (cc & 127);
        CW[i] = p->conv_w[(size_t)(l * 4 + j) * 1536 + ch]; }
    const int tok = tid >> 3, sub = tid & 7;
    const float* nwp = p->gdn_norm_w + l * 128 + sub * 16;
    float nw[16];
#pragma unroll
    for (int i = 0; i < 16; ++i) nw[i] = nwp[i];
    f32x4 S[8];
#pragma unroll
    for (int t = 0; t < 8; ++t) S[t] = (f32x4){0.f, 0.f, 0.f, 0.f};
    for (int sc = 0; sc < SEQ / 64; ++sc) {
        __syncthreads();
        if (tid < 64) {
            const size_t rb = (size_t)b * SEQ + sc * 64 + (tid & 48);
            float acc = 0.f, tot = 0.f;
#pragma unroll
            for (int s = 0; s < 16; ++s) { const float gs = Gg[(rb + s) * 4 + h]; tot += gs; if (s <= (tid & 15)) acc += gs; }
            GC[tid] = acc; EG[tid] = __expf(acc); EGD[tid] = __expf(tot - acc); BE[tid] = BT[(rb + (tid & 15)) * 4 + h];
            if ((tid & 15) == 15) GLC[tid >> 4] = __expf(tot);
        }
        __syncthreads();
        {
            const int s = sc * 64 + tok; const size_t rowg = (size_t)b * SEQ + s;
            float qv[16], kv[16], vv[16];
#pragma unroll
            for (int i = 0; i < 16; ++i) { qv[i] = 0.f; kv[i] = 0.f; vv[i] = 0.f; }
#pragma unroll
            for (int j = 0; j < 4; ++j) {
                if (s - 3 + j >= 0) {
                    const bf16_t* rp = P0 + (rowg - 3 + j) * PW + h * 128 + sub * 16;
                    float t8[8];
                    LAS float* cw = CW + j * 384 + sub * 16;
                    unpack8(*(const uint4*)(rp), t8);
#pragma unroll
                    for (int i = 0; i < 8; ++i) qv[i] += t8[i] * cw[i];
                    unpack8(*(const uint4*)(rp + 8), t8);
#pragma unroll
                    for (int i = 0; i < 8; ++i) qv[8 + i] += t8[i] * cw[8 + i];
                    unpack8(*(const uint4*)(rp + 512), t8);
#pragma unroll
                    for (int i = 0; i < 8; ++i) kv[i] += t8[i] * cw[128 + i];
                    unpack8(*(const uint4*)(rp + 512 + 8), t8);
#pragma unroll
                    for (int i = 0; i < 8; ++i) kv[8 + i] += t8[i] * cw[128 + 8 + i];
                    unpack8(*(const uint4*)(rp + 1024), t8);
#pragma unroll
                    for (int i = 0; i < 8; ++i) vv[i] += t8[i] * cw[256 + i];
                    unpack8(*(const uint4*)(rp + 1024 + 8), t8);
#pragma unroll
                    for (int i = 0; i < 8; ++i) vv[8 + i] += t8[i] * cw[256 + 8 + i];
                }
            }
            float sqq = 0.f, skk = 0.f;
#pragma unroll
            for (int i = 0; i < 16; ++i) { qv[i] = silu(qv[i]); kv[i] = silu(kv[i]); vv[i] = silu(vv[i]); sqq += qv[i] * qv[i]; skk += kv[i] * kv[i]; }
            sqq = sum8(sqq); skk = sum8(skk);
            const float rq = rsqrtf(sqq + EPS) * 0.08838834764831845f, rk = rsqrtf(skk + EPS);
            const float be = BE[tok], eg = EG[tok], egd = EGD[tok];
            u32x4 w0, w1;
            w0.x = cvt2(qv[0] * rq, qv[1] * rq); w0.y = cvt2(qv[2] * rq, qv[3] * rq); w0.z = cvt2(qv[4] * rq, qv[5] * rq); w0.w = cvt2(qv[6] * rq, qv[7] * rq);
            w1.x = cvt2(qv[8] * rq, qv[9] * rq); w1.y = cvt2(qv[10] * rq, qv[11] * rq); w1.z = cvt2(qv[12] * rq, qv[13] * rq); w1.w = cvt2(qv[14] * rq, qv[15] * rq);
            *(LAS u32x4*)(QB + tok * 272 + sub * 32) = w0; *(LAS u32x4*)(QB + tok * 272 + sub * 32 + 16) = w1;
#pragma unroll
            for (int i = 0; i < 16; ++i) kv[i] *= rk;
            w0.x = cvt2(kv[0], kv[1]); w0.y = cvt2(kv[2], kv[3]); w0.z = cvt2(kv[4], kv[5]); w0.w = cvt2(kv[6], kv[7]);
            w1.x = cvt2(kv[8], kv[9]); w1.y = cvt2(kv[10], kv[11]); w1.z = cvt2(kv[12], kv[13]); w1.w = cvt2(kv[14], kv[15]);
            *(LAS u32x4*)(KB + tok * 272 + sub * 32) = w0; *(LAS u32x4*)(KB + tok * 272 + sub * 32 + 16) = w1;
            const float beg = be * eg;
#pragma unroll
            for (int i = 0; i < 16; ++i) { const int row = sub * 16 + i; const int off = TROW(row) + tok * 2;
                *(LAS bf16_t*)(VBT + off) = f2bf(be * vv[i]);
                *(LAS bf16_t*)(KGT + off) = f2bf(beg * kv[i]);
                *(LAS bf16_t*)(KDT + off) = f2bf(egd * kv[i]); }
        }
        __syncthreads();
        {
            const int c = wave >> 1; const bool isq = (wave & 1) != 0;
            LAS unsigned char* AP = isq ? QB : KB;
            f32x4 acc = (f32x4){0.f, 0.f, 0.f, 0.f};
#pragma unroll
            for (int kk = 0; kk < 8; ++kk) {
                const s16x4 a = *(const LAS s16x4*)(AP + (16 * c + r16) * 272 + (16 * kk + 4 * g) * 2);
                const s16x4 bb = *(const LAS s16x4*)(KB + (16 * c + r16) * 272 + (16 * kk + 4 * g) * 2);
                acc = MFMA16(a, bb, acc); }
            const float gj = GC[16 * c + r16];
#pragma unroll
            for (int j = 0; j < 4; ++j) { const int i = 4 * g + j; const float gi = GC[16 * c + i];
                if (isq) { const float val = (r16 <= i) ? acc[j] * __expf(gi - gj) : 0.f; *(LAS bf16_t*)(AQ + c * 640 + i * 40 + r16 * 2) = f2bf(val); }
                else { const float val = (r16 < i) ? acc[j] * __expf(gi - gj) * BE[16 * c + i] : 0.f; AM[c * 320 + i * 20 + r16] = val; } }
        }
        __syncthreads();
        if (wave == 0) {
            LAS float* Ac = AM + g * 320;
            float t[16];
#pragma unroll
            for (int i = 0; i < 16; ++i) {
                float acc = (i == r16) ? 1.f : 0.f;
#pragma unroll
                for (int jv = 0; jv < (i + 3) / 4; ++jv) { const f32x4 a4 = *(const LAS f32x4*)(Ac + i * 20 + 4 * jv);
#pragma unroll
                    for (int e = 0; e < 4; ++e) if (4 * jv + e < i) acc -= a4[e] * t[4 * jv + e]; }
                t[i] = acc;
            }
#pragma unroll
            for (int i = 0; i < 16; ++i) *(LAS bf16_t*)(TM + g * 640 + i * 40 + r16 * 2) = f2bf(t[i]);
        }
        __syncthreads();
        f32x4 U[4];
#pragma unroll
        for (int c = 0; c < 4; ++c) {
            const s16x4 tm = *(const LAS s16x4*)(TM + c * 640 + r16 * 40 + 4 * g * 2);
            const s16x4 bv = *(const LAS s16x4*)(VBT + TROW(16 * wave + r16) + (16 * c + 4 * g) * 2);
            const s16x4 bk = *(const LAS s16x4*)(KGT + TROW(16 * wave + r16) + (16 * c + 4 * g) * 2);
            U[c] = MFMA16(tm, bv, ((f32x4){0.f, 0.f, 0.f, 0.f}));
            const f32x4 wm = MFMA16(tm, bk, ((f32x4){0.f, 0.f, 0.f, 0.f}));
#pragma unroll
            for (int j = 0; j < 4; ++j) *(LAS bf16_t*)(KB + (16 * c + 4 * g + j) * 272 + (16 * wave + r16) * 2) = f2bf(wm[j]);
        }
        __syncthreads();
#pragma unroll
        for (int c = 0; c < 4; ++c) {
            f32x4 P = (f32x4){0.f, 0.f, 0.f, 0.f}, R = (f32x4){0.f, 0.f, 0.f, 0.f};
#pragma unroll
            for (int t = 0; t < 8; ++t) { const s16x4 sb = cvt4(S[t]);
                P = MFMA16(*(const LAS s16x4*)(KB + (16 * c + r16) * 272 + (16 * t + 4 * g) * 2), sb, P);
                R = MFMA16(*(const LAS s16x4*)(QB + (16 * c + r16) * 272 + (16 * t + 4 * g) * 2), sb, R); }
            const f32x4 vnew = U[c] - P;
            const s16x4 bv = cvt4(vnew);
            const f32x4 eg4 = *(const LAS f32x4*)(EG + 16 * c + 4 * g);
            R = MFMA16(*(const LAS s16x4*)(AQ + c * 640 + r16 * 40 + 4 * g * 2), bv, R * eg4);
#pragma unroll
            for (int j = 0; j < 4; ++j) OB[(16 * c + 4 * g + j) * 132 + 16 * wave + r16] = R[j];
            const float glc = GLC[c];
#pragma unroll
            for (int t = 0; t < 8; ++t) S[t] = MFMA16(*(const LAS s16x4*)(KDT + TROW(16 * t + r16) + (16 * c + 4 * g) * 2), bv, S[t] * glc);
        }
        __syncthreads();
        {
            const size_t rowg = (size_t)b * SEQ + sc * 64 + tok;
            float o[16]; float ss = 0.f;
#pragma unroll
            for (int i = 0; i < 4; ++i) { const f32x4 v = *(const LAS f32x4*)(OB + tok * 132 + sub * 16 + 4 * i); o[4 * i] = v[0]; o[4 * i + 1] = v[1]; o[4 * i + 2] = v[2]; o[4 * i + 3] = v[3]; ss += v[0] * v[0] + v[1] * v[1] + v[2] * v[2] + v[3] * v[3]; }
            ss = sum8(ss);
            const float rstd = rsqrtf(ss * (1.f / 128.f) + EPS);
            const bf16_t* zp = P0 + rowg * PW + 1536 + h * 128 + sub * 16;
            float z0[8], z1[8]; unpack8(*(const uint4*)zp, z0); unpack8(*(const uint4*)(zp + 8), z1);
            float y0[8], y1[8];
#pragma unroll
            for (int i = 0; i < 8; ++i) { y0[i] = o[i] * rstd * nw[i] * silu(z0[i]); y1[i] = o[8 + i] * rstd * nw[8 + i] * silu(z1[i]); }
            bf16_t* yp = YA + rowg * 512 + h * 128 + sub * 16;
            *(uint4*)yp = pack8(y0); *(uint4*)(yp + 8) = pack8(y1);
        }
    }
}

__device__ void phase_rec(KP p, int l, LAS unsigned char* lds) {
    for (int item = blockIdx.x; item < 128; item += gridDim.x) {
        if (item < 64) gdn_chunk(p, l, item, lds);
        else hgrn_chunk(p, l, item - 64, lds);
    }
}

__device__ void phase_gn(KP p, int l) {
    const int tid = threadIdx.x, lane = tid & 63, wave = tid >> 6;
    bf16_t* OA = (bf16_t*)(p->ws + WS_XN); bf16_t* OB = OA + (size_t)MTOK * 512;
    for (int wi = blockIdx.x * 8 + wave; wi < MTOK; wi += gridDim.x * 8) {
        const int br = 0; const size_t row = (size_t)wi;
        bf16_t* O = (br ? OB : OA) + row * 512 + lane * 8;
        const bf16_t* Z = (const bf16_t*)(p->ws + (br ? WS_P1 : WS_P0)) + row * PW + 1536 + lane * 8;
        const float* nw = (br ? p->hg_norm_w : p->gdn_norm_w) + l * 128 + (lane & 15) * 8;
        float o[8], z[8]; unpack8(*(const uint4*)O, o); unpack8(*(const uint4*)Z, z);
        float ss = 0.f;
#pragma unroll
        for (int i = 0; i < 8; ++i) ss += o[i] * o[i];
        ss = sum16(ss);
        const float rstd = rsqrtf(ss * (1.f / 128.f) + EPS);
        const float4 w0 = *(const float4*)nw, w1 = *(const float4*)(nw + 4);
        const float wv[8] = {w0.x, w0.y, w0.z, w0.w, w1.x, w1.y, w1.z, w1.w};
#pragma unroll
        for (int i = 0; i < 8; ++i) o[i] = o[i] * rstd * wv[i] * silu(z[i]);
        *(uint4*)O = pack8(o);
    }
}

__device__ void phase_final(KP p) {
    const int tid = threadIdx.x, lane = tid & 63, wave = tid >> 6;
    float4 nwv[4];
#pragma unroll
    for (int c = 0; c < 4; ++c) nwv[c] = *(const float4*)(p->final_norm_w + c * 256 + lane * 4);
    for (int row = blockIdx.x * 8 + wave; row < MTOK; row += gridDim.x * 8) {
        float* hr = p->out + (size_t)row * DM;
        float4 v[4]; float ss = 0.f;
#pragma unroll
        for (int c = 0; c < 4; ++c) { v[c] = *(const float4*)(hr + c * 256 + lane * 4); ss += v[c].x * v[c].x + v[c].y * v[c].y + v[c].z * v[c].z + v[c].w * v[c].w; }
        ss = sum64(ss);
        const float rstd = rsqrtf(ss * (1.f / DM) + EPS);
#pragma unroll
        for (int c = 0; c < 4; ++c) { float4 o; o.x = v[c].x * rstd * nwv[c].x; o.y = v[c].y * rstd * nwv[c].y; o.z = v[c].z * rstd * nwv[c].z; o.w = v[c].w * rstd * nwv[c].w;
            *(float4*)(hr + c * 256 + lane * 4) = o; }
    }
}

__global__ void __launch_bounds__(512, 2) fwd_kernel(Params p_arg) {
    extern __shared__ __attribute__((aligned(16))) unsigned char smem[];
    cg::grid_group grid = cg::this_grid();
    LAS unsigned char* lds = (LAS unsigned char*)smem;
    KP p = (KP)__builtin_amdgcn_kernarg_segment_ptr();
#define RELOAD() asm volatile("" : "+s"(p))
#ifndef NO_W
    phase_weights(p, (LAS float*)lds);
#endif
    RELOAD();
#ifndef NO_N
    phase_norm(p, 0, p->x, (LAS float*)lds);
#endif
    grid.sync();
    for (int l = 0; l < DEPTH; ++l) {
        RELOAD();
#ifndef NO_G1
        { unsigned char* ws = p->ws;
          pg8::Gemm g{(const bf16_t*)(ws + WS_XN), (const bf16_t*)(ws + WS_W + (size_t)l * SZ_WL), MTOK, NPROJ, DM}; pg8::StaticOrder S; S.init(MTOK, NPROJ, (int)gridDim.x, (int)blockIdx.x);
          EpiSplit E{(bf16_t*)(ws + WS_P0)}; pg8::gemm_phase<EpiSplit, pg8::StaticOrder, false>(lds, g, S, E, nullptr); }
#endif
        grid.sync();
        RELOAD();
#ifndef NO_R
        phase_rec(p, l, lds);
#endif
        grid.sync();
        RELOAD();
#ifndef NO_B1
        { unsigned char* ws = p->ws;
          pg8::Gemm g{(const bf16_t*)(ws + WS_XN), (const bf16_t*)(ws + WS_W + (size_t)l * SZ_WL + SZ_WIN), MTOK, DM, 512}; pg8::StaticOrder S; S.init(MTOK, DM, (int)gridDim.x, (int)blockIdx.x);
          EpiGate<false> E{(bf16_t*)(ws + WS_P0), (const bf16_t*)(ws + WS_P2), nullptr}; pg8::gemm_phase<EpiGate<false>, pg8::StaticOrder, false>(lds, g, S, E, nullptr); }
#endif
        __syncthreads();
        RELOAD();
#ifndef NO_B2
        { unsigned char* ws = p->ws;
          pg8::Gemm g{(const bf16_t*)(ws + WS_XN) + (size_t)MTOK * 512, (const bf16_t*)(ws + WS_W + (size_t)l * SZ_WL + SZ_WIN + SZ_WB), MTOK, DM, 512}; pg8::StaticOrder S; S.init(MTOK, DM, (int)gridDim.x, (int)blockIdx.x);
          EpiGate<true> E{(bf16_t*)(ws + WS_P1), (const bf16_t*)(ws + WS_P2) + 1024, (const bf16_t*)(ws + WS_P0)}; pg8::gemm_phase<EpiGate<true>, pg8::StaticOrder, false>(lds, g, S, E, nullptr); }
#endif
        grid.sync();
        RELOAD();
#ifndef NO_O
        { unsigned char* ws = p->ws;
          pg8::Gemm g{(const bf16_t*)(ws + WS_P1), (const bf16_t*)(ws + WS_W + (size_t)l * SZ_WL + SZ_WIN + 2 * SZ_WB), MTOK, DM, DM}; pg8::StaticOrder S; S.init(MTOK, DM, (int)gridDim.x, (int)blockIdx.x);
          EpiRes E{l == 0 ? p->x : (const float*)p->out, p->out}; pg8::gemm_phase<EpiRes, pg8::StaticOrder, false>(lds, g, S, E, nullptr); }
#endif
        grid.sync();
        RELOAD();
#ifndef NO_N
        if (l + 1 < DEPTH) { phase_norm(p, l + 1, p->out, (LAS float*)lds); grid.sync(); }
#endif
    }
    RELOAD();
#ifndef NO_F
    phase_final(p);
#endif
}

extern "C" void kernel_launch(void* const* d_in, const int* in_sizes, int n_in, void* d_out, int out_size, void* d_ws, size_t ws_size, hipStream_t stream) {
    static int grid = 0;
    if (grid == 0) {
        if (n_in != 12 || out_size != MTOK * DM || ws_size < WS_END) { fprintf(stderr, "kernel_launch: unexpected shapes (n_in %d out %d ws %zu, need %zu); nothing launched\n", n_in, out_size, ws_size, (size_t)WS_END); grid = -1; return; }
        int dev = 0, cus = 0, per_cu = 0;
        if (hipGetDevice(&dev) != hipSuccess || hipDeviceGetAttribute(&cus, hipDeviceAttributeMultiprocessorCount, dev) != hipSuccess) { grid = -1; return; }
        if (hipFuncSetAttribute((const void*)fwd_kernel, hipFuncAttributeMaxDynamicSharedMemorySize, LDS_BYTES) != hipSuccess) { fprintf(stderr, "kernel_launch: hipFuncSetAttribute failed\n"); grid = -1; return; }
        if (hipOccupancyMaxActiveBlocksPerMultiprocessor(&per_cu, (const void*)fwd_kernel, 512, LDS_BYTES) != hipSuccess || per_cu < 1) { fprintf(stderr, "kernel_launch: occupancy query says %d\n", per_cu); per_cu = 1; }
        (void)hipGetLastError();
        grid = cus;
    }
    if (grid < 0) return;
    Params p{};
    p.x = (const float*)d_in[0]; p.norm_w = (const float*)d_in[1]; p.w_in = (const float*)d_in[2]; p.conv_w = (const float*)d_in[3]; p.a_log = (const float*)d_in[4]; p.dt_bias = (const float*)d_in[5];
    p.gdn_norm_w = (const float*)d_in[6]; p.hg_lb = (const float*)d_in[7]; p.hg_norm_w = (const float*)d_in[8]; p.w_branch = (const float*)d_in[9]; p.w_out = (const float*)d_in[10]; p.final_norm_w = (const float*)d_in[11];
    p.out = (float*)d_out; p.ws = (unsigned char*)d_ws;
    void* args[] = {&p};
    hipError_t e = hipLaunchCooperativeKernel((const void*)fwd_kernel, dim3(grid), dim3(512), args, LDS_BYTES, stream);
    if (e != hipSuccess) fprintf(stderr, "kernel_launch: cooperative launch failed: %s (grid %d)\n", hipGetErrorString(e), grid);
}
```

```cpp
#include <hip/hip_runtime.h>
#include <hip/hip_cooperative_groups.h>
#include <cstdio>
namespace cg = cooperative_groups;
namespace pg8 {
#define PG8_LAS __attribute__((address_space(3)))
typedef unsigned short bf16_t;
typedef short bf16x8 __attribute__((ext_vector_type(8)));
typedef float f32x4 __attribute__((ext_vector_type(4)));
typedef unsigned u32x4 __attribute__((ext_vector_type(4)));
constexpr int BM = 256, BK = 64, HALF = 128, HTB = HALF * BK * 2  , STAGE_BYTES = 8 * HTB, NXCD = 8, WGM = 8;

__host__ __device__ __forceinline__ int lds_byte(int r, int c) { const int st = (r >> 4) * 2 + (c >> 5), rr = r & 15, cc = c & 31, ob = rr * 64 + cc * 2; return st * 1024 + (ob ^ (((ob >> 9) & 1) << 5)); }
__host__ __device__ __forceinline__ void stage_rc(int b, int& R, int& C) { const int st = b / 1024, sb = b % 1024, swz = sb ^ (((sb >> 9) & 1) << 5); R = (st >> 1) * 16 + swz / 64; C = (st & 1) * 32 + (swz % 64) / 2; }
__host__ __device__ __forceinline__ int perm32(int rho) { const int n = rho >> 4, i = rho & 15; return 8 * (i >> 2) + 4 * n + (i & 3); }

struct Unit { int pm, pn; };
struct Gemm { const bf16_t* A; const bf16_t* Bt; int M, N, K; };

struct StaticOrder {
    int nM, nN, nwg, G, c;
    __host__ __device__ void init(int M, int N, int G_, int c_) { nM = M / BM; nN = N / BM; nwg = nM * nN; G = G_; c = c_; }
    __host__ __device__ bool next(int i, Unit& u) const {
        const long L = (long)i * G + c; if (L >= nwg) return false;
        int wgid = (int)L; { const int q = nwg / NXCD, r = nwg % NXCD, xcd = wgid % NXCD, off = wgid / NXCD; wgid = (xcd < r ? xcd * (q + 1) : r * (q + 1) + (xcd - r) * q) + off; }
        const int nig = WGM * nN, gid = wgid / nig, fm = gid * WGM, gsz = (nM - fm) < WGM ? (nM - fm) : WGM;
        u.pm = fm + ((wgid % nig) % gsz); u.pn = (wgid % nig) / gsz; return true;
    }
    __device__ __forceinline__ void a_ready(const Unit&) const {}
    __device__ __forceinline__ void done(const Unit&) const {}
};
__device__ __forceinline__ unsigned cvt_pk_bf16(float lo, float hi) { unsigned r; asm volatile("v_cvt_pk_bf16_f32 %0, %1, %2" : "=v"(r) : "v"(lo), "v"(hi)); return r; }
typedef float f32x2 __attribute__((ext_vector_type(2)));
template <class Epi, class Sched, bool STAMP = false>
__device__ __forceinline__ void gemm_phase(PG8_LAS unsigned char* lds, const Gemm g, const Sched& S, const Epi& E, unsigned long long* stamps) {
    int tid_ = threadIdx.x; asm volatile("" : "+v"(tid_));
    const int tid = tid_, wid = __builtin_amdgcn_readfirstlane(tid >> 6), lane = tid & 63, wr = wid >> 2, wc = wid & 3, fr = lane & 15, fq = lane >> 4;
    const int K = g.K, nt = K / BK;
#define PG8_STAMP() do {} while (0)
    PG8_STAMP();
    unsigned voffA[2], voffB[2];
#pragma unroll
    for (int i = 0; i < 2; ++i) { int R, C; stage_rc(tid * 16 + i * 8192, R, C); const int Rb = Epi::PERM ? ((R & ~31) + perm32(R & 31)) : R;
        voffA[i] = (unsigned)(R * K + C) * 2u; voffB[i] = (unsigned)(Rb * K + C) * 2u; }
    const size_t kstep = (size_t)(BK * 2);
    const size_t hstep = (size_t)HALF * K * 2;
    const size_t tstep = 2 * hstep;
    const unsigned ldsw = (unsigned)wid * 1024u;
    const int aoff = lds_byte(wr * 64 + fr, fq * 8), boff = lds_byte(wc * 32 + fr, fq * 8);
#define PG8_SA(b, h) (((b) * 2 + (h)) * HTB)
#define PG8_SB(b, h) ((4 + (b) * 2 + (h)) * HTB)
#define PG8_STAGE(bufoff, gbase, voff) do { _Pragma("unroll") for (int _i = 0; _i < 2; ++_i) \
        __builtin_amdgcn_global_load_lds((const unsigned*)((const char*)(gbase) + (voff)[_i]), (PG8_LAS unsigned*)(lds + (bufoff) + ldsw + _i * 8192), 16, 0, 0); } while (0)
#define PG8_LDA(dst, b, h) do { _Pragma("unroll") for (int m = 0; m < 4; ++m) _Pragma("unroll") for (int k = 0; k < 2; ++k) dst[m][k] = *(const PG8_LAS bf16x8*)(lds + PG8_SA(b, h) + aoff + m * 2048 + k * 1024); } while (0)
#define PG8_LDB(dst, b, h) do { _Pragma("unroll") for (int n = 0; n < 2; ++n) _Pragma("unroll") for (int k = 0; k < 2; ++k) dst[n][k] = *(const PG8_LAS bf16x8*)(lds + PG8_SB(b, h) + boff + n * 2048 + k * 1024); } while (0)
#define PG8_MMA(ai, bj, At, Bt) do { __builtin_amdgcn_s_setprio(1); _Pragma("unroll") for (int m = 0; m < 4; ++m) _Pragma("unroll") for (int n = 0; n < 2; ++n) _Pragma("unroll") for (int k = 0; k < 2; ++k) \
        acc[ai][bj][m][n] = __builtin_amdgcn_mfma_f32_16x16x32_bf16(Bt[n][k], At[m][k], acc[ai][bj][m][n], 0, 0, 0); __builtin_amdgcn_s_setprio(0); } while (0)
#define PG8_WAIT_V(n) asm volatile("s_waitcnt vmcnt(" #n ")" ::: "memory")
#define PG8_WAIT_L(n) asm volatile("s_waitcnt lgkmcnt(" #n ")" ::: "memory")
#define PG8_BAR __builtin_amdgcn_s_barrier()
#define PG8_SCHED __builtin_amdgcn_sched_barrier(0)
    Unit cur, nxt; int ui = 0;
    if (!S.next(0, cur)) return;
    f32x4 acc[2][2][4][2];
#pragma unroll
    for (int a = 0; a < 2; ++a)
#pragma unroll
        for (int b = 0; b < 2; ++b)
#pragma unroll
            for (int m = 0; m < 4; ++m)
#pragma unroll
                for (int n = 0; n < 2; ++n) acc[a][b][m][n] = (f32x4){0.f, 0.f, 0.f, 0.f};
    bf16x8 At[4][2], B0[2][2], B1[2][2];
    const char* cA = (const char*)g.A + (size_t)cur.pm * tstep; const char* cB = (const char*)g.Bt + (size_t)cur.pn * tstep;
    S.a_ready(cur);
    PG8_STAGE(PG8_SB(0, 0), cB, voffB); PG8_STAGE(PG8_SA(0, 0), cA, voffA); PG8_STAGE(PG8_SB(0, 1), cB + hstep, voffB); PG8_STAGE(PG8_SA(0, 1), cA + hstep, voffA);
    if (wr == 1) PG8_BAR;
    PG8_WAIT_V(4); PG8_BAR;
    PG8_STAGE(PG8_SB(1, 0), cB + kstep, voffB); PG8_STAGE(PG8_SA(1, 0), cA + kstep, voffA); PG8_STAGE(PG8_SB(1, 1), cB + hstep + kstep, voffB);
    PG8_WAIT_V(6); PG8_BAR;
    PG8_STAMP();
    for (;;) {
        const bool has_next = S.next(ui + 1, nxt);
        const char* nA = has_next ? (const char*)g.A + (size_t)nxt.pm * tstep : cA; const char* nB = has_next ? (const char*)g.Bt + (size_t)nxt.pn * tstep : cB;
        for (int t = 0; t < nt; t += 2) {
            const bool last = (t == nt - 2);
            const char* a1 = cA + (size_t)(t + 1) * kstep;
            const char* a2 = last ? nA : cA + (size_t)(t + 2) * kstep; const char* b2 = last ? nB : cB + (size_t)(t + 2) * kstep;
            const char* a3 = a2 + kstep; const char* b3 = b2 + kstep;
            if (last && has_next) S.a_ready(nxt);
            PG8_LDB(B0, 0, 0); PG8_SCHED; PG8_LDA(At, 0, 0); PG8_STAGE(PG8_SA(1, 1), a1 + hstep, voffA);
            PG8_WAIT_L(8); PG8_BAR; PG8_WAIT_L(0); PG8_MMA(0, 0, At, B0); PG8_BAR; PG8_SCHED;
            PG8_LDB(B1, 0, 1); PG8_STAGE(PG8_SB(0, 0), b2, voffB);
            PG8_BAR; PG8_WAIT_L(0); PG8_MMA(0, 1, At, B1); PG8_BAR;
            PG8_LDA(At, 0, 1); PG8_STAGE(PG8_SA(0, 0), a2, voffA);
            PG8_BAR; PG8_WAIT_L(0); PG8_MMA(1, 0, At, B0); PG8_BAR; PG8_SCHED;
            PG8_STAGE(PG8_SB(0, 1), b2 + hstep, voffB);
            PG8_WAIT_V(6); PG8_BAR; PG8_MMA(1, 1, At, B1); PG8_BAR;
            PG8_LDB(B0, 1, 0); PG8_SCHED; PG8_LDA(At, 1, 0); PG8_STAGE(PG8_SA(0, 1), a2 + hstep, voffA);
            PG8_WAIT_L(8); PG8_BAR; PG8_WAIT_L(0); PG8_MMA(0, 0, At, B0); PG8_BAR; PG8_SCHED;
            PG8_LDB(B1, 1, 1); PG8_STAGE(PG8_SB(1, 0), b3, voffB);
            PG8_BAR; PG8_WAIT_L(0); PG8_MMA(0, 1, At, B1); PG8_BAR;
            PG8_LDA(At, 1, 1); PG8_STAGE(PG8_SA(1, 0), a3, voffA);
            PG8_BAR; PG8_WAIT_L(0); PG8_MMA(1, 0, At, B0); PG8_BAR; PG8_SCHED;
            PG8_STAGE(PG8_SB(1, 1), b3 + hstep, voffB);
            PG8_WAIT_V(6); PG8_BAR; PG8_MMA(1, 1, At, B1); PG8_BAR;
        }
        PG8_STAMP();
        if constexpr (!Epi::AFTER_DRAIN) { E(acc, cur, wr, wc, fr, fq); S.done(cur); }
        PG8_STAMP();
        if (!has_next) break;
#pragma unroll
        for (int a = 0; a < 2; ++a)
#pragma unroll
            for (int b = 0; b < 2; ++b)
#pragma unroll
                for (int m = 0; m < 4; ++m)
#pragma unroll
                    for (int n = 0; n < 2; ++n) acc[a][b][m][n] = (f32x4){0.f, 0.f, 0.f, 0.f};
        cur = nxt; cA = nA; cB = nB; ++ui;
    }
    PG8_WAIT_V(0);
    if (wr == 0) PG8_BAR;
    PG8_BAR;
    if constexpr (Epi::AFTER_DRAIN) { E.fused(acc, cur, wr, wc, fr, fq, lds, wid, lane); S.done(cur); }
    PG8_STAMP();
#undef PG8_STAMP
#undef PG8_SA
#undef PG8_SB
#undef PG8_STAGE
#undef PG8_LDA
#undef PG8_LDB
#undef PG8_MMA
#undef PG8_WAIT_V
#undef PG8_WAIT_L
#undef PG8_BAR
#undef PG8_SCHED
}
}

using pg8::bf16_t; using pg8::f32x4; using pg8::u32x4;
typedef float f32x2v __attribute__((ext_vector_type(2)));
#define LAS __attribute__((address_space(3)))
constexpr int DM = 1024, NB = 16, SEQ = 4096, MTOK = NB * SEQ, DEPTH = 2, INC = 6152, NPROJ = 6144, PW = 2048;
constexpr float EPS = 1e-6f;
constexpr int LDS_BYTES = 131072;
constexpr size_t SZ_P = (size_t)MTOK * PW * 2;
constexpr size_t WS_P0 = 0, WS_P1 = SZ_P, WS_P2 = 2 * SZ_P, WS_XN = 3 * SZ_P;
constexpr size_t SZ_XN = (size_t)MTOK * DM * 2;
constexpr size_t WS_W = WS_XN + SZ_XN;
constexpr size_t SZ_WIN = (size_t)NPROJ * DM * 2, SZ_WB = (size_t)DM * 512 * 2, SZ_WO = (size_t)DM * DM * 2;
constexpr size_t SZ_WL = SZ_WIN + 2 * SZ_WB + SZ_WO;
constexpr size_t WS_G = WS_W + DEPTH * SZ_WL;
constexpr size_t SZ_G = (size_t)MTOK * 4 * 4;
constexpr size_t WS_BETA = WS_G + SZ_G;
constexpr size_t WS_END = WS_BETA + SZ_G;

struct Params {
    const float* x; const float* norm_w; const float* w_in; const float* conv_w; const float* a_log; const float* dt_bias;
    const float* gdn_norm_w; const float* hg_lb; const float* hg_norm_w; const float* w_branch; const float* w_out; const float* final_norm_w;
    float* out; unsigned char* ws;
};

typedef const __attribute__((address_space(4))) Params* KP;
__device__ __forceinline__ float bflo(unsigned u) { return __uint_as_float(u << 16); }
__device__ __forceinline__ float bfhi(unsigned u) { return __uint_as_float(u & 0xffff0000u); }
__device__ __forceinline__ bf16_t f2bf(float f) { unsigned u = __float_as_uint(f); u += 0x7FFFu + ((u >> 16) & 1u); return (bf16_t)(u >> 16); }
__device__ __forceinline__ float sigm(float x) { return 1.f / (1.f + __expf(-x)); }
__device__ __forceinline__ float silu(float x) { return x / (1.f + __expf(-x)); }
__device__ __forceinline__ void unpack8(const uint4 u, float (&f)[8]) { f[0] = bflo(u.x); f[1] = bfhi(u.x); f[2] = bflo(u.y); f[3] = bfhi(u.y); f[4] = bflo(u.z); f[5] = bfhi(u.z); f[6] = bflo(u.w); f[7] = bfhi(u.w); }
__device__ __forceinline__ uint4 pack8(const float (&f)[8]) { uint4 u; u.x = pg8::cvt_pk_bf16(f[0], f[1]); u.y = pg8::cvt_pk_bf16(f[2], f[3]); u.z = pg8::cvt_pk_bf16(f[4], f[5]); u.w = pg8::cvt_pk_bf16(f[6], f[7]); return u; }
template <int CTRL> __device__ __forceinline__ float dppf(float x) { return __int_as_float(__builtin_amdgcn_update_dpp(0, __float_as_int(x), CTRL, 0xf, 0xf, true)); }
__device__ __forceinline__ float sum8(float x) { x += dppf<0xB1>(x); x += dppf<0x4E>(x); x += dppf<0x141>(x); return x; }
__device__ __forceinline__ float sum16(float x) { x = sum8(x); x += dppf<0x140>(x); return x; }
__device__ __forceinline__ float sum64(float x) { x = sum16(x); x += __shfl_xor(x, 16); x += __shfl_xor(x, 32); return x; }

struct EpiSplit {
    static constexpr bool PERM = true, AFTER_DRAIN = false;
    bf16_t* O;
    __device__ __forceinline__ void operator()(const f32x4 (&acc)[2][2][4][2], const pg8::Unit& u, int wr, int wc, int fr, int fq) const {
        const int row0 = u.pm * 256 + wr * 64 + fr; int colt = u.pn * 256; const int t = colt / PW; colt -= t * PW;
        bf16_t* base = O + (size_t)t * MTOK * PW; const int col0 = colt + wc * 32 + 8 * fq;
#pragma unroll
        for (int ai = 0; ai < 2; ++ai)
#pragma unroll
            for (int m = 0; m < 4; ++m) { bf16_t* rowp = base + (size_t)(row0 + ai * 128 + m * 16) * PW + col0;
#pragma unroll
                for (int bj = 0; bj < 2; ++bj) { const f32x4 v0 = acc[ai][bj][m][0], v1 = acc[ai][bj][m][1];
                    u32x4 w; w.x = pg8::cvt_pk_bf16(v0[0], v0[1]); w.y = pg8::cvt_pk_bf16(v0[2], v0[3]); w.z = pg8::cvt_pk_bf16(v1[0], v1[1]); w.w = pg8::cvt_pk_bf16(v1[2], v1[3]);
                    *(u32x4*)(rowp + bj * 128) = w; } }
    }
};
template <bool ADD> struct EpiGate {
    static constexpr bool PERM = true, AFTER_DRAIN = false;
    bf16_t* O; const bf16_t* gate; const bf16_t* addsrc;
    __device__ __forceinline__ void operator()(const f32x4 (&acc)[2][2][4][2], const pg8::Unit& u, int wr, int wc, int fr, int fq) const {
        const int row0 = u.pm * 256 + wr * 64 + fr; const int col0 = u.pn * 256 + wc * 32 + 8 * fq;
#pragma unroll
        for (int ai = 0; ai < 2; ++ai)
#pragma unroll
            for (int m = 0; m < 4; ++m) { const size_t r = (size_t)(row0 + ai * 128 + m * 16);
#pragma unroll
                for (int bj = 0; bj < 2; ++bj) { const int c = col0 + bj * 128;
                    const uint4 gu = *(const uint4*)(gate + r * PW + c); float gf[8]; unpack8(gu, gf);
                    const f32x4 v0 = acc[ai][bj][m][0], v1 = acc[ai][bj][m][1];
                    float v[8] = {v0[0], v0[1], v0[2], v0[3], v1[0], v1[1], v1[2], v1[3]};
#pragma unroll
                    for (int j = 0; j < 8; ++j) v[j] *= sigm(gf[j]);
                    if (ADD) { const uint4 au = *(const uint4*)(addsrc + r * DM + c); float af[8]; unpack8(au, af);
#pragma unroll
                        for (int j = 0; j < 8; ++j) v[j] += af[j]; }
                    *(uint4*)(O + r * DM + c) = pack8(v); } }
    }
};
struct EpiRes {
    static constexpr bool PERM = false, AFTER_DRAIN = false;
    const float* base; float* out;
    __device__ __forceinline__ void operator()(const f32x4 (&acc)[2][2][4][2], const pg8::Unit& u, int wr, int wc, int fr, int fq) const {
        const int row0 = u.pm * 256 + wr * 64 + fr, col0 = u.pn * 256 + wc * 32 + 4 * fq;
#pragma unroll
        for (int ai = 0; ai < 2; ++ai)
#pragma unroll
            for (int m = 0; m < 4; ++m) { const size_t off = (size_t)(row0 + ai * 128 + m * 16) * DM + col0;
#pragma unroll
                for (int bj = 0; bj < 2; ++bj)
#pragma unroll
                    for (int n = 0; n < 2; ++n) { const size_t o2 = off + bj * 128 + n * 16; *(f32x4*)(out + o2) = *(const f32x4*)(base + o2) + acc[ai][bj][m][n]; } }
    }
};

__device__ void convT(const float* src, int ld, int col0, int N, int K, bf16_t* dst, LAS float* tile) {
    const int tid = threadIdx.x; const int ntn = N / 64, ntk = K / 64;
    for (int t = blockIdx.x; t < ntn * ntk; t += gridDim.x) {
        const int n0 = (t % ntn) * 64, k0 = (t / ntn) * 64;
        { const int kk = tid >> 6, nn = tid & 63;
#pragma unroll
          for (int i = 0; i < 8; ++i) tile[(kk + 8 * i) * 65 + nn] = src[(size_t)(k0 + kk + 8 * i) * ld + col0 + n0 + nn]; }
        __syncthreads();
        { const int nn = tid >> 6, kk = tid & 63;
#pragma unroll
          for (int i = 0; i < 8; ++i) dst[(size_t)(n0 + nn + 8 * i) * K + k0 + kk] = f2bf(tile[kk * 65 + nn + 8 * i]); }
        __syncthreads();
    }
}
__device__ void phase_weights(KP p, LAS float* tile) {
    for (int l = 0; l < DEPTH; ++l) {
        unsigned char* wl = p->ws + WS_W + (size_t)l * SZ_WL;
        const float* win = p->w_in + (size_t)l * DM * INC;
        convT(win, INC, 0, 1536, DM, (bf16_t*)wl, tile);
        convT(win, INC, 1544, NPROJ - 1536, DM, (bf16_t*)wl + (size_t)1536 * DM, tile);
        convT(p->w_branch + (size_t)(l * 2 + 0) * 512 * DM, DM, 0, DM, 512, (bf16_t*)(wl + SZ_WIN), tile);
        convT(p->w_branch + (size_t)(l * 2 + 1) * 512 * DM, DM, 0, DM, 512, (bf16_t*)(wl + SZ_WIN + SZ_WB), tile);
        convT(p->w_out + (size_t)l * DM * DM, DM, 0, DM, DM, (bf16_t*)(wl + SZ_WIN + 2 * SZ_WB), tile);
    }
}

__device__ void phase_norm(KP p, int l, const float* hsrc, LAS float* wab) {
    const int tid = threadIdx.x, lane = tid & 63, wave = tid >> 6;
    const float* win = p->w_in + (size_t)l * DM * INC;
    __syncthreads();
    for (int i = tid; i < 8192; i += 512) { const int k = i >> 3, j = i & 7; wab[j * 1024 + k] = win[(size_t)k * INC + 1536 + j]; }
    __syncthreads();
    const float* nw = p->norm_w + l * DM;
    bf16_t* XN = (bf16_t*)(p->ws + WS_XN); float* G = (float*)(p->ws + WS_G); float* BT = (float*)(p->ws + WS_BETA);
    float4 nwv[4];
#pragma unroll
    for (int c = 0; c < 4; ++c) nwv[c] = *(const float4*)(nw + c * 256 + lane * 4);
    const float alog = p->a_log[l * 4 + (lane & 3)], dtb = p->dt_bias[l * 4 + (lane & 3)];
    for (int row = blockIdx.x * 8 + wave; row < MTOK; row += gridDim.x * 8) {
        const float* hr = hsrc + (size_t)row * DM;
        float4 v[4]; float ss = 0.f;
#pragma unroll
        for (int c = 0; c < 4; ++c) { v[c] = *(const float4*)(hr + c * 256 + lane * 4); ss += v[c].x * v[c].x + v[c].y * v[c].y + v[c].z * v[c].z + v[c].w * v[c].w; }
        ss = sum64(ss);
        const float rstd = rsqrtf(ss * (1.f / DM) + EPS);
        float acc[8];
#pragma unroll
        for (int j = 0; j < 8; ++j) acc[j] = 0.f;
#pragma unroll
        for (int c = 0; c < 4; ++c) {
            const float x0 = v[c].x * rstd * nwv[c].x, x1 = v[c].y * rstd * nwv[c].y, x2 = v[c].z * rstd * nwv[c].z, x3 = v[c].w * rstd * nwv[c].w;
            uint2 pk; pk.x = pg8::cvt_pk_bf16(x0, x1); pk.y = pg8::cvt_pk_bf16(x2, x3);
            *(uint2*)(XN + (size_t)row * DM + c * 256 + lane * 4) = pk;
#pragma unroll
            for (int j = 0; j < 8; ++j) { const f32x4 w = *(const LAS f32x4*)(wab + j * 1024 + c * 256 + lane * 4); acc[j] += x0 * w[0] + x1 * w[1] + x2 * w[2] + x3 * w[3]; }
        }
#pragma unroll
        for (int j = 0; j < 8; ++j) acc[j] = sum64(acc[j]);
        if (lane < 4) {
            const float a = lane == 0 ? acc[0] : lane == 1 ? acc[1] : lane == 2 ? acc[2] : acc[3];
            const float bb = lane == 0 ? acc[4] : lane == 1 ? acc[5] : lane == 2 ? acc[6] : acc[7];
            const float z = a + dtb; const float sp = z > 20.f ? z : log1pf(expf(z));
            G[(size_t)row * 4 + lane] = -expf(alog) * sp;
            BT[(size_t)row * 4 + lane] = 1.f / (1.f + expf(-bb));
        }
    }
}

typedef short s16x4 __attribute__((ext_vector_type(4)));
typedef __bf16 bf16x2_t __attribute__((ext_vector_type(2)));
typedef unsigned u32x2v __attribute__((ext_vector_type(2)));
__device__ __forceinline__ unsigned cvt2(float lo, float hi) { f32x2v v = {lo, hi}; bf16x2_t r = __builtin_convertvector(v, bf16x2_t); return __builtin_bit_cast(unsigned, r); }
__device__ __forceinline__ s16x4 cvt4(f32x4 v) { u32x2v u = {cvt2(v[0], v[1]), cvt2(v[2], v[3])}; return __builtin_bit_cast(s16x4, u); }
#define MFMA16(a, b, c) __builtin_amdgcn_mfma_f32_16x16x16bf16_1k((a), (b), (c), 0, 0, 0)

__device__ void gdn_tokenrec(KP p, int l, int idx, LAS float* lds) {
    int tid_ = threadIdx.x; asm volatile("" : "+v"(tid_));
    const int tid = tid_, lane = tid & 63, wave = tid >> 6;
    LAS float* sq = lds; LAS float* sk = lds + 8192; LAS float* sv = lds + 16384; LAS float* so = lds + 20480;
    LAS float* seg = lds + 24576; LAS float* sbe = seg + 64; LAS float* scw = seg + 128;
    const float* G = (const float*)(p->ws + WS_G); const float* BT = (const float*)(p->ws + WS_BETA);
    bf16_t* OUT = (bf16_t*)(p->ws + WS_XN);
    const int r = lane & 15, cp = wave * 4 + (lane >> 4);
    const int tok = tid >> 3, sub = tid & 7;
    const int b = idx >> 3, h = (idx >> 1) & 3, half = idx & 1;
    __syncthreads();
    for (int i = tid; i < 1280; i += 512) { const int j = i / 320, cc = i % 320;
        const int ch = cc < 128 ? h * 128 + cc : (cc < 256 ? 512 + h * 128 + (cc - 128) : 1024 + h * 128 + half * 64 + (cc - 256));
        scw[i] = p->conv_w[(size_t)(l * 4 + j) * 1536 + ch]; }
    float S[8][2];
#pragma unroll
    for (int i = 0; i < 8; ++i) { S[i][0] = 0.f; S[i][1] = 0.f; }
    const bf16_t* PB = (const bf16_t*)(p->ws + WS_P0);
    for (int ck = 0; ck < SEQ / 64; ++ck) {
        __syncthreads();
        const int s = ck * 64 + tok; const size_t rowg = (size_t)b * SEQ + s;
        {
            float qv[16], kv[16], vv[8];
#pragma unroll
            for (int i = 0; i < 16; ++i) { qv[i] = 0.f; kv[i] = 0.f; }
#pragma unroll
            for (int i = 0; i < 8; ++i) vv[i] = 0.f;
#pragma unroll
            for (int j = 0; j < 4; ++j) {
                if (s - 3 + j >= 0) {
                    const bf16_t* rp = PB + (rowg - 3 + j) * PW;
                    float t8[8];
                    LAS float* cw = scw + j * 320;
                    unpack8(*(const uint4*)(rp + h * 128 + sub * 16), t8);
#pragma unroll
                    for (int i = 0; i < 8; ++i) qv[i] += t8[i] * cw[sub * 16 + i];
                    unpack8(*(const uint4*)(rp + h * 128 + sub * 16 + 8), t8);
#pragma unroll
                    for (int i = 0; i < 8; ++i) qv[8 + i] += t8[i] * cw[sub * 16 + 8 + i];
                    unpack8(*(const uint4*)(rp + 512 + h * 128 + sub * 16), t8);
#pragma unroll
                    for (int i = 0; i < 8; ++i) kv[i] += t8[i] * cw[128 + sub * 16 + i];
                    unpack8(*(const uint4*)(rp + 512 + h * 128 + sub * 16 + 8), t8);
#pragma unroll
                    for (int i = 0; i < 8; ++i) kv[8 + i] += t8[i] * cw[128 + sub * 16 + 8 + i];
                    unpack8(*(const uint4*)(rp + 1024 + h * 128 + half * 64 + sub * 8), t8);
#pragma unroll
                    for (int i = 0; i < 8; ++i) vv[i] += t8[i] * cw[256 + sub * 8 + i];
                }
            }
            float sqq = 0.f, skk = 0.f;
#pragma unroll
            for (int i = 0; i < 16; ++i) { qv[i] = silu(qv[i]); kv[i] = silu(kv[i]); sqq += qv[i] * qv[i]; skk += kv[i] * kv[i]; }
#pragma unroll
            for (int i = 0; i < 8; ++i) vv[i] = silu(vv[i]);
            sqq = sum8(sqq); skk = sum8(skk);
            const float rq = rsqrtf(sqq + EPS) * 0.08838834764831845f, rk = rsqrtf(skk + EPS);
#pragma unroll
            for (int i = 0; i < 16; ++i) { sq[tok * 128 + sub * 16 + i] = qv[i] * rq; sk[tok * 128 + sub * 16 + i] = kv[i] * rk; }
#pragma unroll
            for (int i = 0; i < 8; ++i) sv[tok * 64 + sub * 8 + i] = vv[i];
            if (sub == 0) { seg[tok] = __expf(G[rowg * 4 + h]); sbe[tok] = BT[rowg * 4 + h]; }
        }
        __syncthreads();
        for (int t = 0; t < 64; ++t) {
            const f32x4 k0 = *(const LAS f32x4*)(sk + t * 128 + r * 8), k1 = *(const LAS f32x4*)(sk + t * 128 + r * 8 + 4);
            const f32x4 q0 = *(const LAS f32x4*)(sq + t * 128 + r * 8), q1 = *(const LAS f32x4*)(sq + t * 128 + r * 8 + 4);
            const f32x2v v2 = *(const LAS f32x2v*)(sv + t * 64 + cp * 2);
            const float eg = seg[t], be = sbe[t];
            const float kk[8] = {k0[0], k0[1], k0[2], k0[3], k1[0], k1[1], k1[2], k1[3]};
            const float qq[8] = {q0[0], q0[1], q0[2], q0[3], q1[0], q1[1], q1[2], q1[3]};
            float p0 = 0.f, p1 = 0.f;
#pragma unroll
            for (int i = 0; i < 8; ++i) { p0 += kk[i] * S[i][0]; p1 += kk[i] * S[i][1]; }
            p0 = sum16(p0); p1 = sum16(p1);
            const float d0 = be * (v2[0] - eg * p0), d1 = be * (v2[1] - eg * p1);
            float o0 = 0.f, o1 = 0.f;
#pragma unroll
            for (int i = 0; i < 8; ++i) { S[i][0] = eg * S[i][0] + kk[i] * d0; S[i][1] = eg * S[i][1] + kk[i] * d1; o0 += qq[i] * S[i][0]; o1 += qq[i] * S[i][1]; }
            o0 = sum16(o0); o1 = sum16(o1);
            if (r == 0) *(LAS f32x2v*)(so + t * 64 + cp * 2) = (f32x2v){o0, o1};
        }
        __syncthreads();
        { float o8[8];
#pragma unroll
          for (int i = 0; i < 8; ++i) o8[i] = so[tok * 64 + sub * 8 + i];
          *(uint4*)(OUT + rowg * 512 + h * 128 + half * 64 + sub * 8) = pack8(o8); }
    }
}

__device__ void hgrn_chunk(KP p, int l, int idx, LAS unsigned char* lds) {
    int tid_ = threadIdx.x; asm volatile("" : "+v"(tid_));
    const int tid = tid_, lane = tid & 63, wave = __builtin_amdgcn_readfirstlane(tid >> 6), g = lane >> 4, r16 = lane & 15;
    LAS unsigned char* QT = lds;
    LAS unsigned char* KT = lds + 16896;
    LAS unsigned char* KDT = lds + 33792;
    LAS unsigned char* VT = lds + 52224;
    LAS float* GL = (LAS float*)(lds + 70656);
    LAS unsigned char* AQ = lds + 72704;
    LAS float* OB = (LAS float*)(lds + 75264);
    LAS float* SLB = (LAS float*)(lds + 109056);
    const int b = idx >> 2, h = idx & 3;
    const bf16_t* P1 = (const bf16_t*)(p->ws + WS_P1);
    bf16_t* YB = (bf16_t*)(p->ws + WS_XN) + (size_t)MTOK * 512;
    __syncthreads();
    if (tid < 128) { const int c = h * 128 + tid; float mx = -1e30f;
        for (int i = 0; i < DEPTH; ++i) mx = fmaxf(mx, p->hg_lb[i * 512 + c]);
        float den = 0.f, num = 0.f;
        for (int i = 0; i < DEPTH; ++i) { const float e = expf(p->hg_lb[i * 512 + c] - mx); den += e; if (i >= 1 && i <= l) num += e; }
        SLB[tid] = num / den; }
    __syncthreads();
    const int sc_c = tid & 127, sc_cc = tid >> 7;
    const float lb = SLB[sc_c];
    const int tok = tid >> 3, sub = tid & 7;
    const float* nwp = p->hg_norm_w + l * 128 + sub * 16;
    float nw[16];
#pragma unroll
    for (int i = 0; i < 16; ++i) nw[i] = nwp[i];
    f32x4 S[8];
#pragma unroll
    for (int t = 0; t < 8; ++t) S[t] = (f32x4){0.f, 0.f, 0.f, 0.f};
    for (int sc = 0; sc < SEQ / 64; ++sc) {
        __syncthreads();
        const size_t rowg = (size_t)b * SEQ + sc * 64 + tok;
        const uint4 zr0 = *(const uint4*)(P1 + rowg * PW + 1536 + h * 128 + sub * 16), zr1 = *(const uint4*)(P1 + rowg * PW + 1536 + h * 128 + sub * 16 + 8);
        unsigned pf = 0u;
        if (sc + 1 < SEQ / 64 && sub < 6) pf = *(const volatile unsigned*)(P1 + (rowg + 64) * PW + (sub >> 1) * 512 + h * 128 + (sub & 1) * 64);
        {
            const size_t row0 = (size_t)b * SEQ + sc * 64 + sc_cc * 16;
            const bf16_t* base = P1 + row0 * PW + h * 128 + sc_c;
            float f[16], q[16]; unsigned short vraw[16];
#pragma unroll
            for (int t = 0; t < 16; ++t) { q[t] = bflo((unsigned)base[(size_t)t * PW]); const float x = bflo((unsigned)base[(size_t)t * PW + 512]); f[t] = lb + (1.f - lb) * sigm(x); vraw[t] = base[(size_t)t * PW + 1024]; }
            float pre[16], suf[16]; float run = 1.f;
#pragma unroll
            for (int t = 0; t < 16; ++t) { run *= f[t]; pre[t] = run; }
            GL[sc_cc * 128 + sc_c] = run;
            run = 1.f;
#pragma unroll
            for (int t = 15; t >= 0; --t) { suf[t] = run; run *= f[t]; }
            float kd[16];
#pragma unroll
            for (int t = 0; t < 16; ++t) { const float k = 1.f - f[t]; const float ip = 1.f / fmaxf(pre[t], 1e-30f);
                *(LAS bf16_t*)(QT + (sc_cc * 16 + t) * 264 + sc_c * 2) = (bf16_t)cvt2(q[t] * pre[t], 0.f);
                *(LAS bf16_t*)(KT + (sc_cc * 16 + t) * 264 + sc_c * 2) = (bf16_t)cvt2(k * ip, 0.f);
                kd[t] = k * suf[t]; }
            u32x4 w0, w1;
            w0.x = cvt2(kd[0], kd[1]); w0.y = cvt2(kd[2], kd[3]); w0.z = cvt2(kd[4], kd[5]); w0.w = cvt2(kd[6], kd[7]);
            w1.x = cvt2(kd[8], kd[9]); w1.y = cvt2(kd[10], kd[11]); w1.z = cvt2(kd[12], kd[13]); w1.w = cvt2(kd[14], kd[15]);
            *(LAS u32x4*)(KDT + sc_c * 144 + sc_cc * 32) = w0; *(LAS u32x4*)(KDT + sc_c * 144 + sc_cc * 32 + 16) = w1;
            w0.x = vraw[0] | ((unsigned)vraw[1] << 16); w0.y = vraw[2] | ((unsigned)vraw[3] << 16); w0.z = vraw[4] | ((unsigned)vraw[5] << 16); w0.w = vraw[6] | ((unsigned)vraw[7] << 16);
            w1.x = vraw[8] | ((unsigned)vraw[9] << 16); w1.y = vraw[10] | ((unsigned)vraw[11] << 16); w1.z = vraw[12] | ((unsigned)vraw[13] << 16); w1.w = vraw[14] | ((unsigned)vraw[15] << 16);
            *(LAS u32x4*)(VT + sc_c * 144 + sc_cc * 32) = w0; *(LAS u32x4*)(VT + sc_c * 144 + sc_cc * 32 + 16) = w1;
        }
        __syncthreads();
        if (wave < 4) {
            const int c = wave; f32x4 acc = (f32x4){0.f, 0.f, 0.f, 0.f};
#pragma unroll
            for (int kk = 0; kk < 8; ++kk) {
                const s16x4 a = *(const LAS s16x4*)(QT + (16 * c + r16) * 264 + (16 * kk + 4 * g) * 2);
                const s16x4 bb = *(const LAS s16x4*)(KT + (16 * c + r16) * 264 + (16 * kk + 4 * g) * 2);
                acc = MFMA16(a, bb, acc); }
#pragma unroll
            for (int j = 0; j < 4; ++j) { const float val = (r16 <= 4 * g + j) ? acc[j] : 0.f; *(LAS bf16_t*)(AQ + c * 640 + (4 * g + j) * 40 + r16 * 2) = (bf16_t)cvt2(val, 0.f); }
        }
        __syncthreads();
#pragma unroll 1
        for (int c = 0; c < 4; ++c) {
            const s16x4 bv = *(const LAS s16x4*)(VT + (16 * wave + r16) * 144 + (16 * c + 4 * g) * 2);
            f32x4 R = (f32x4){0.f, 0.f, 0.f, 0.f};
#pragma unroll
            for (int t = 0; t < 8; ++t) { const s16x4 a = *(const LAS s16x4*)(QT + (16 * c + r16) * 264 + (16 * t + 4 * g) * 2); R = MFMA16(a, cvt4(S[t]), R); }
            R = MFMA16(*(const LAS s16x4*)(AQ + c * 640 + r16 * 40 + 4 * g * 2), bv, R);
#pragma unroll
            for (int j = 0; j < 4; ++j) OB[(16 * c + 4 * g + j) * 132 + 16 * wave + r16] = R[j];
#pragma unroll
            for (int t = 0; t < 8; ++t) { const f32x4 gl4 = *(const LAS f32x4*)(GL + c * 128 + 16 * t + 4 * g);
                const s16x4 a = *(const LAS s16x4*)(KDT + (16 * t + r16) * 144 + (16 * c + 4 * g) * 2);
                S[t] = MFMA16(a, bv, S[t] * gl4); }
        }
        __syncthreads();
        {
            asm volatile("" :: "v"(pf));
            float o[16]; float ss = 0.f;
#pragma unroll
            for (int i = 0; i < 4; ++i) { const f32x4 v = *(const LAS f32x4*)(OB + tok * 132 + sub * 16 + 4 * i); o[4 * i] = v[0]; o[4 * i + 1] = v[1]; o[4 * i + 2] = v[2]; o[4 * i + 3] = v[3]; ss += v[0] * v[0] + v[1] * v[1] + v[2] * v[2] + v[3] * v[3]; }
            ss = sum8(ss);
            const float rstd = rsqrtf(ss * (1.f / 128.f) + EPS);
            float z0[8], z1[8]; unpack8(zr0, z0); unpack8(zr1, z1);
            float y0[8], y1[8];
#pragma unroll
            for (int i = 0; i < 8; ++i) { y0[i] = o[i] * rstd * nw[i] * silu(z0[i]); y1[i] = o[8 + i] * rstd * nw[8 + i] * silu(z1[i]); }
            bf16_t* yp = YB + rowg * 512 + h * 128 + sub * 16;
            *(uint4*)yp = pack8(y0); *(uint4*)(yp + 8) = pack8(y1);
        }
    }
}

#define TROW(row) ((row) * 144 + ((row) >> 4) * 8)
__device__ void gdn_chunk(KP p, int l, int idx, LAS unsigned char* lds) {
    int tid_ = threadIdx.x; asm volatile("" : "+v"(tid_));
    const int tid = tid_, lane = tid & 63, wave = __builtin_amdgcn_readfirstlane(tid >> 6), g = lane >> 4, r16 = lane & 15;
    LAS unsigned char* QB = lds;
    LAS unsigned char* KB = lds + 17408;
    LAS unsigned char* VBT = lds + 34816;
    LAS unsigned char* KGT = lds + 53312;
    LAS unsigned char* KDT = lds + 71808;
    LAS unsigned char* TM = lds + 90304;
    LAS unsigned char* AQ = lds + 92864;
    LAS float* AM = (LAS float*)(lds + 95424);
    LAS float* GC = (LAS float*)(lds + 100544);
    LAS float* EG = GC + 64; LAS float* EGD = GC + 128; LAS float* BE = GC + 192; LAS float* GLC = GC + 256;
    LAS float* CW = (LAS float*)(lds + 101632);
    LAS float* OB = (LAS float*)(lds + 34816);
    const int b = idx >> 2, h = idx & 3;
    const bf16_t* P0 = (const bf16_t*)(p->ws + WS_P0);
    const float* Gg = (const float*)(p->ws + WS_G); const float* BT = (const float*)(p->ws + WS_BETA);
    bf16_t* YA = (bf16_t*)(p->ws + WS_XN);
    __syncthreads();
    for (int i = tid; i < 1536; i += 512) { const int j = i / 384, cc = i % 384;
        const int ch = (cc >> 7) * 512 + h * 128 + (cc & 127);
        CW[i] = p->conv_w[(size_t)(l * 4 + j) * 1536 + ch]; }
    const int tok = tid >> 3, sub = tid & 7;
    const float* nwp = p->gdn_norm_w + l * 128 + sub * 16;
    float nw[16];
#pragma unroll
    for (int i = 0; i < 16; ++i) nw[i] = nwp[i];
    f32x4 S[8];
#pragma unroll
    for (int t = 0; t < 8; ++t) S[t] = (f32x4){0.f, 0.f, 0.f, 0.f};
    float gpre = 0.f, bpre = 0.f;
    if (tid < 64) { const size_t r0 = (size_t)b * SEQ + tid; gpre = Gg[r0 * 4 + h]; bpre = BT[r0 * 4 + h]; }
    for (int sc = 0; sc < SEQ / 64; ++sc) {
        __syncthreads();
        const size_t rowg = (size_t)b * SEQ + sc * 64 + tok;
        const uint4 zr0 = *(const uint4*)(P0 + rowg * PW + 1536 + h * 128 + sub * 16), zr1 = *(const uint4*)(P0 + rowg * PW + 1536 + h * 128 + sub * 16 + 8);
        unsigned pf = 0u;
        if (sc + 1 < SEQ / 64 && sub < 6) pf = *(const volatile unsigned*)(P0 + (rowg + 64) * PW + (sub >> 1) * 512 + h * 128 + (sub & 1) * 64);
        if (tid < 64) {
            float x = gpre;
            x += dppf<0x111>(x); x += dppf<0x112>(x); x += dppf<0x114>(x); x += dppf<0x118>(x);
            const float tot = __shfl(x, (lane & 48) | 15);
            GC[tid] = x; EG[tid] = __expf(x); EGD[tid] = __expf(tot - x); BE[tid] = bpre;
            if ((tid & 15) == 15) GLC[tid >> 4] = __expf(tot);
            if (sc + 1 < SEQ / 64) { const size_t r1 = (size_t)b * SEQ + (sc + 1) * 64 + tid; gpre = Gg[r1 * 4 + h]; bpre = BT[r1 * 4 + h]; }
        }
        __syncthreads();
        {
            const int s = sc * 64 + tok;
            float qv[16], kv[16], vv[16];
#pragma unroll
            for (int i = 0; i < 16; ++i) { qv[i] = 0.f; kv[i] = 0.f; vv[i] = 0.f; }
#pragma unroll
            for (int j = 0; j < 4; ++j) {
                if (s - 3 + j >= 0) {
                    const bf16_t* rp = P0 + (rowg - 3 + j) * PW + h * 128 + sub * 16;
                    float t8[8];
                    LAS float* cw = CW + j * 384 + sub * 16;
                    unpack8(*(const uint4*)(rp), t8);
#pragma unroll
                    for (int i = 0; i < 8; ++i) qv[i] += t8[i] * cw[i];
                    unpack8(*(const uint4*)(rp + 8), t8);
#pragma unroll
                    for (int i = 0; i < 8; ++i) qv[8 + i] += t8[i] * cw[8 + i];
                    unpack8(*(const uint4*)(rp + 512), t8);
#pragma unroll
                    for (int i = 0; i < 8; ++i) kv[i] += t8[i] * cw[128 + i];
                    unpack8(*(const uint4*)(rp + 512 + 8), t8);
#pragma unroll
                    for (int i = 0; i < 8; ++i) kv[8 + i] += t8[i] * cw[128 + 8 + i];
                    unpack8(*(const uint4*)(rp + 1024), t8);
#pragma unroll
                    for (int i = 0; i < 8; ++i) vv[i] += t8[i] * cw[256 + i];
                    unpack8(*(const uint4*)(rp + 1024 + 8), t8);
#pragma unroll
                    for (int i = 0; i < 8; ++i) vv[8 + i] += t8[i] * cw[256 + 8 + i];
                }
            }
            float sqq = 0.f, skk = 0.f;
#pragma unroll
            for (int i = 0; i < 16; ++i) { qv[i] = silu(qv[i]); kv[i] = silu(kv[i]); vv[i] = silu(vv[i]); sqq += qv[i] * qv[i]; skk += kv[i] * kv[i]; }
            sqq = sum8(sqq); skk = sum8(skk);
            const float rq = rsqrtf(sqq + EPS) * 0.08838834764831845f, rk = rsqrtf(skk + EPS);
            const float be = BE[tok], eg = EG[tok], egd = EGD[tok];
            u32x4 w0, w1;
            w0.x = cvt2(qv[0] * rq, qv[1] * rq); w0.y = cvt2(qv[2] * rq, qv[3] * rq); w0.z = cvt2(qv[4] * rq, qv[5] * rq); w0.w = cvt2(qv[6] * rq, qv[7] * rq);
            w1.x = cvt2(qv[8] * rq, qv[9] * rq); w1.y = cvt2(qv[10] * rq, qv[11] * rq); w1.z = cvt2(qv[12] * rq, qv[13] * rq); w1.w = cvt2(qv[14] * rq, qv[15] * rq);
            *(LAS u32x4*)(QB + tok * 272 + sub * 32) = w0; *(LAS u32x4*)(QB + tok * 272 + sub * 32 + 16) = w1;
#pragma unroll
            for (int i = 0; i < 16; ++i) kv[i] *= rk;
            w0.x = cvt2(kv[0], kv[1]); w0.y = cvt2(kv[2], kv[3]); w0.z = cvt2(kv[4], kv[5]); w0.w = cvt2(kv[6], kv[7]);
            w1.x = cvt2(kv[8], kv[9]); w1.y = cvt2(kv[10], kv[11]); w1.z = cvt2(kv[12], kv[13]); w1.w = cvt2(kv[14], kv[15]);
            *(LAS u32x4*)(KB + tok * 272 + sub * 32) = w0; *(LAS u32x4*)(KB + tok * 272 + sub * 32 + 16) = w1;
            const float beg = be * eg;
#pragma unroll
            for (int i = 0; i < 16; ++i) { const int row = sub * 16 + i; const int off = TROW(row) + tok * 2;
                *(LAS bf16_t*)(VBT + off) = (bf16_t)cvt2(be * vv[i], 0.f);
                *(LAS bf16_t*)(KGT + off) = (bf16_t)cvt2(beg * kv[i], 0.f);
                *(LAS bf16_t*)(KDT + off) = (bf16_t)cvt2(egd * kv[i], 0.f); }
        }
        __syncthreads();
        {
            const int c = wave >> 1; const bool isq = (wave & 1) != 0;
            LAS unsigned char* AP = isq ? QB : KB;
            f32x4 acc = (f32x4){0.f, 0.f, 0.f, 0.f};
#pragma unroll
            for (int kk = 0; kk < 8; ++kk) {
                const s16x4 a = *(const LAS s16x4*)(AP + (16 * c + r16) * 272 + (16 * kk + 4 * g) * 2);
                const s16x4 bb = *(const LAS s16x4*)(KB + (16 * c + r16) * 272 + (16 * kk + 4 * g) * 2);
                acc = MFMA16(a, bb, acc); }
            const float gj = GC[16 * c + r16];
#pragma unroll
            for (int j = 0; j < 4; ++j) { const int i = 4 * g + j; const float gi = GC[16 * c + i];
                if (isq) { const float val = (r16 <= i) ? acc[j] * __expf(gi - gj) : 0.f; *(LAS bf16_t*)(AQ + c * 640 + i * 40 + r16 * 2) = (bf16_t)cvt2(val, 0.f); }
                else { const float val = (r16 < i) ? acc[j] * __expf(gi - gj) * BE[16 * c + i] : 0.f; AM[c * 320 + i * 20 + r16] = val; } }
        }
        __syncthreads();
        if (wave == 0) {
            LAS float* Ac = AM + g * 320;
            float t[16];
#pragma unroll
            for (int i = 0; i < 16; ++i) {
                float acc = (i == r16) ? 1.f : 0.f;
#pragma unroll
                for (int jv = 0; jv < (i + 3) / 4; ++jv) { const f32x4 a4 = *(const LAS f32x4*)(Ac + i * 20 + 4 * jv);
#pragma unroll
                    for (int e = 0; e < 4; ++e) if (4 * jv + e < i) acc -= a4[e] * t[4 * jv + e]; }
                t[i] = acc;
            }
#pragma unroll
            for (int i = 0; i < 16; ++i) *(LAS bf16_t*)(TM + g * 640 + i * 40 + r16 * 2) = (bf16_t)cvt2(t[i], 0.f);
        }
        __syncthreads();
        f32x4 U[4];
#pragma unroll
        for (int c = 0; c < 4; ++c) {
            const s16x4 tm = *(const LAS s16x4*)(TM + c * 640 + r16 * 40 + 4 * g * 2);
            const s16x4 bv = *(const LAS s16x4*)(VBT + TROW(16 * wave + r16) + (16 * c + 4 * g) * 2);
            const s16x4 bk = *(const LAS s16x4*)(KGT + TROW(16 * wave + r16) + (16 * c + 4 * g) * 2);
            U[c] = MFMA16(tm, bv, ((f32x4){0.f, 0.f, 0.f, 0.f}));
            const f32x4 wm = MFMA16(tm, bk, ((f32x4){0.f, 0.f, 0.f, 0.f}));
#pragma unroll
            for (int j = 0; j < 4; ++j) *(LAS bf16_t*)(KB + (16 * c + 4 * g + j) * 272 + (16 * wave + r16) * 2) = (bf16_t)cvt2(wm[j], 0.f);
        }
        __syncthreads();
#pragma unroll
        for (int c = 0; c < 4; ++c) {
            f32x4 P = (f32x4){0.f, 0.f, 0.f, 0.f}, R = (f32x4){0.f, 0.f, 0.f, 0.f};
#pragma unroll
            for (int t = 0; t < 8; ++t) { const s16x4 sb = cvt4(S[t]);
                P = MFMA16(*(const LAS s16x4*)(KB + (16 * c + r16) * 272 + (16 * t + 4 * g) * 2), sb, P);
                R = MFMA16(*(const LAS s16x4*)(QB + (16 * c + r16) * 272 + (16 * t + 4 * g) * 2), sb, R); }
            const f32x4 vnew = U[c] - P;
            const s16x4 bv = cvt4(vnew);
            const f32x4 eg4 = *(const LAS f32x4*)(EG + 16 * c + 4 * g);
            R = MFMA16(*(const LAS s16x4*)(AQ + c * 640 + r16 * 40 + 4 * g * 2), bv, R * eg4);
#pragma unroll
            for (int j = 0; j < 4; ++j) OB[(16 * c + 4 * g + j) * 132 + 16 * wave + r16] = R[j];
            const float glc = GLC[c];
#pragma unroll
            for (int t = 0; t < 8; ++t) S[t] = MFMA16(*(const LAS s16x4*)(KDT + TROW(16 * t + r16) + (16 * c + 4 * g) * 2), bv, S[t] * glc);
        }
        __syncthreads();
        {
            asm volatile("" :: "v"(pf));
            float o[16]; float ss = 0.f;
#pragma unroll
            for (int i = 0; i < 4; ++i) { const f32x4 v = *(const LAS f32x4*)(OB + tok * 132 + sub * 16 + 4 * i); o[4 * i] = v[0]; o[4 * i + 1] = v[1]; o[4 * i + 2] = v[2]; o[4 * i + 3] = v[3]; ss += v[0] * v[0] + v[1] * v[1] + v[2] * v[2] + v[3] * v[3]; }
            ss = sum8(ss);
            const float rstd = rsqrtf(ss * (1.f / 128.f) + EPS);
            float z0[8], z1[8]; unpack8(zr0, z0); unpack8(zr1, z1);
            float y0[8], y1[8];
#pragma unroll
            for (int i = 0; i < 8; ++i) { y0[i] = o[i] * rstd * nw[i] * silu(z0[i]); y1[i] = o[8 + i] * rstd * nw[8 + i] * silu(z1[i]); }
            bf16_t* yp = YA + rowg * 512 + h * 128 + sub * 16;
            *(uint4*)yp = pack8(y0); *(uint4*)(yp + 8) = pack8(y1);
        }
    }
}

__device__ void phase_rec(KP p, int l, LAS unsigned char* lds) {
    for (int item = blockIdx.x; item < 128; item += gridDim.x) {
        if (item < 64) gdn_chunk(p, l, item, lds);
        else hgrn_chunk(p, l, item - 64, lds);
    }
}

__device__ void phase_gn(KP p, int l) {
    const int tid = threadIdx.x, lane = tid & 63, wave = tid >> 6;
    bf16_t* OA = (bf16_t*)(p->ws + WS_XN); bf16_t* OB = OA + (size_t)MTOK * 512;
    for (int wi = blockIdx.x * 8 + wave; wi < MTOK; wi += gridDim.x * 8) {
        const int br = 0; const size_t row = (size_t)wi;
        bf16_t* O = (br ? OB : OA) + row * 512 + lane * 8;
        const bf16_t* Z = (const bf16_t*)(p->ws + (br ? WS_P1 : WS_P0)) + row * PW + 1536 + lane * 8;
        const float* nw = (br ? p->hg_norm_w : p->gdn_norm_w) + l * 128 + (lane & 15) * 8;
        float o[8], z[8]; unpack8(*(const uint4*)O, o); unpack8(*(const uint4*)Z, z);
        float ss = 0.f;
#pragma unroll
        for (int i = 0; i < 8; ++i) ss += o[i] * o[i];
        ss = sum16(ss);
        const float rstd = rsqrtf(ss * (1.f / 128.f) + EPS);
        const float4 w0 = *(const float4*)nw, w1 = *(const float4*)(nw + 4);
        const float wv[8] = {w0.x, w0.y, w0.z, w0.w, w1.x, w1.y, w1.z, w1.w};
#pragma unroll
        for (int i = 0; i < 8; ++i) o[i] = o[i] * rstd * wv[i] * silu(z[i]);
        *(uint4*)O = pack8(o);
    }
}

__device__ void phase_final(KP p) {
    const int tid = threadIdx.x, lane = tid & 63, wave = tid >> 6;
    float4 nwv[4];
#pragma unroll
    for (int c = 0; c < 4; ++c) nwv[c] = *(const float4*)(p->final_norm_w + c * 256 + lane * 4);
    for (int row = blockIdx.x * 8 + wave; row < MTOK; row += gridDim.x * 8) {
        float* hr = p->out + (size_t)row * DM;
        float4 v[4]; float ss = 0.f;
#pragma unroll
        for (int c = 0; c < 4; ++c) { v[c] = *(const float4*)(hr + c * 256 + lane * 4); ss += v[c].x * v[c].x + v[c].y * v[c].y + v[c].z * v[c].z + v[c].w * v[c].w; }
        ss = sum64(ss);
        const float rstd = rsqrtf(ss * (1.f / DM) + EPS);
#pragma unroll
        for (int c = 0; c < 4; ++c) { float4 o; o.x = v[c].x * rstd * nwv[c].x; o.y = v[c].y * rstd * nwv[c].y; o.z = v[c].z * rstd * nwv[c].z; o.w = v[c].w * rstd * nwv[c].w;
            *(float4*)(hr + c * 256 + lane * 4) = o; }
    }
}

__global__ void __launch_bounds__(512, 2) fwd_kernel(Params p_arg) {
    extern __shared__ __attribute__((aligned(16))) unsigned char smem[];
    cg::grid_group grid = cg::this_grid();
    LAS unsigned char* lds = (LAS unsigned char*)smem;
    KP p = (KP)__builtin_amdgcn_kernarg_segment_ptr();
#define RELOAD() asm volatile("" : "+s"(p))
#ifndef NO_W
    phase_weights(p, (LAS float*)lds);
#endif
    RELOAD();
#ifndef NO_N
    phase_norm(p, 0, p->x, (LAS float*)lds);
#endif
    grid.sync();
    for (int l = 0; l < DEPTH; ++l) {
        RELOAD();
#ifndef NO_G1
        { unsigned char* ws = p->ws;
          pg8::Gemm g{(const bf16_t*)(ws + WS_XN), (const bf16_t*)(ws + WS_W + (size_t)l * SZ_WL), MTOK, NPROJ, DM}; pg8::StaticOrder S; S.init(MTOK, NPROJ, (int)gridDim.x, (int)blockIdx.x);
          EpiSplit E{(bf16_t*)(ws + WS_P0)}; pg8::gemm_phase<EpiSplit, pg8::StaticOrder, false>(lds, g, S, E, nullptr); }
#endif
        grid.sync();
        RELOAD();
#ifndef NO_R
        phase_rec(p, l, lds);
#endif
        grid.sync();
        RELOAD();
#ifndef NO_B1
        { unsigned char* ws = p->ws;
          pg8::Gemm g{(const bf16_t*)(ws + WS_XN), (const bf16_t*)(ws + WS_W + (size_t)l * SZ_WL + SZ_WIN), MTOK, DM, 512}; pg8::StaticOrder S; S.init(MTOK, DM, (int)gridDim.x, (int)blockIdx.x);
          EpiGate<false> E{(bf16_t*)(ws + WS_P0), (const bf16_t*)(ws + WS_P2), nullptr}; pg8::gemm_phase<EpiGate<false>, pg8::StaticOrder, false>(lds, g, S, E, nullptr); }
#endif
        __syncthreads();
        RELOAD();
#ifndef NO_B2
        { unsigned char* ws = p->ws;
          pg8::Gemm g{(const bf16_t*)(ws + WS_XN) + (size_t)MTOK * 512, (const bf16_t*)(ws + WS_W + (size_t)l * SZ_WL + SZ_WIN + SZ_WB), MTOK, DM, 512}; pg8::StaticOrder S; S.init(MTOK, DM, (int)gridDim.x, (int)blockIdx.x);
          EpiGate<true> E{(bf16_t*)(ws + WS_P1), (const bf16_t*)(ws + WS_P2) + 1024, (const bf16_t*)(ws + WS_P0)}; pg8::gemm_phase<EpiGate<true>, pg8::StaticOrder, false>(lds, g, S, E, nullptr); }
#endif
        grid.sync();
        RELOAD();
#ifndef NO_O
        { unsigned char* ws = p->ws;
          pg8::Gemm g{(const bf16_t*)(ws + WS_P1), (const bf16_t*)(ws + WS_W + (size_t)l * SZ_WL + SZ_WIN + 2 * SZ_WB), MTOK, DM, DM}; pg8::StaticOrder S; S.init(MTOK, DM, (int)gridDim.x, (int)blockIdx.x);
          EpiRes E{l == 0 ? p->x : (const float*)p->out, p->out}; pg8::gemm_phase<EpiRes, pg8::StaticOrder, false>(lds, g, S, E, nullptr); }
#endif
        grid.sync();
        RELOAD();
#ifndef NO_N
        if (l + 1 < DEPTH) { phase_norm(p, l + 1, p->out, (LAS float*)lds); grid.sync(); }
#endif
    }
    RELOAD();
#ifndef NO_F
    phase_final(p);
#endif
}

extern "C" void kernel_launch(void* const* d_in, const int* in_sizes, int n_in, void* d_out, int out_size, void* d_ws, size_t ws_size, hipStream_t stream) {
    static int grid = 0;
    if (grid == 0) {
        if (n_in != 12 || out_size != MTOK * DM || ws_size < WS_END) { fprintf(stderr, "kernel_launch: unexpected shapes (n_in %d out %d ws %zu, need %zu); nothing launched\n", n_in, out_size, ws_size, (size_t)WS_END); grid = -1; return; }
        int dev = 0, cus = 0, per_cu = 0;
        if (hipGetDevice(&dev) != hipSuccess || hipDeviceGetAttribute(&cus, hipDeviceAttributeMultiprocessorCount, dev) != hipSuccess) { grid = -1; return; }
        if (hipFuncSetAttribute((const void*)fwd_kernel, hipFuncAttributeMaxDynamicSharedMemorySize, LDS_BYTES) != hipSuccess) { fprintf(stderr, "kernel_launch: hipFuncSetAttribute failed\n"); grid = -1; return; }
        if (hipOccupancyMaxActiveBlocksPerMultiprocessor(&per_cu, (const void*)fwd_kernel, 512, LDS_BYTES) != hipSuccess || per_cu < 1) { fprintf(stderr, "kernel_launch: occupancy query says %d\n", per_cu); per_cu = 1; }
        (void)hipGetLastError();
        grid = cus;
    }
    if (grid < 0) return;
    Params p{};
    p.x = (const float*)d_in[0]; p.norm_w = (const float*)d_in[1]; p.w_in = (const float*)d_in[2]; p.conv_w = (const float*)d_in[3]; p.a_log = (const float*)d_in[4]; p.dt_bias = (const float*)d_in[5];
    p.gdn_norm_w = (const float*)d_in[6]; p.hg_lb = (const float*)d_in[7]; p.hg_norm_w = (const float*)d_in[8]; p.w_branch = (const float*)d_in[9]; p.w_out = (const float*)d_in[10]; p.final_norm_w = (const float*)d_in[11];
    p.out = (float*)d_out; p.ws = (unsigned char*)d_ws;
    void* args[] = {&p};
    hipError_t e = hipLaunchCooperativeKernel((const void*)fwd_kernel, dim3(grid), dim3(512), args, LDS_BYTES, stream);
    if (e != hipSuccess) fprintf(stderr, "kernel_launch: cooperative launch failed: %s (grid %d)\n", hipGetErrorString(e), grid);
}
```
